# Optimizing an MI355X kernel written in HIP

```python
import jax, jax.numpy as jnp
from jax import lax
import numpy as np

D_MODEL = 4096
BATCH = 4
SEQ = 2048
DEPTH = 2
DEC_BATCH = 32
DEC_SEQ = 1
PAST_LEN = 16384
PAGE_SIZE = 128

N_MIXERS = 2
N_GMLP_LAYERS = (DEPTH + N_MIXERS - 1) // N_MIXERS
N_SWA_LAYERS = DEPTH // N_MIXERS
NORM_EPS = 1e-6
CHUNK = 128
D_GMLP = D_MODEL
N_GROUPS = 16
GROUP_DIM = D_GMLP // N_GROUPS
HEAD_DIM = 64
N_HEADS = D_MODEL // HEAD_DIM
N_KV_HEADS = 8
Q_PER_KV = N_HEADS // N_KV_HEADS
WINDOW = 128
BLOCK = WINDOW
ATTN_SCALE = HEAD_DIM ** -0.5
D_FF = 256 * ((8 * D_MODEL // 3 + 255) // 256)
CONV_W = 3

kernel_name = "hybrid_chunkgmlp_swa_sink_convffn_step"


def rms_norm(x, g):
    xf = x.astype(jnp.float32)
    y = xf * lax.rsqrt(jnp.mean(xf * xf, axis=-1, keepdims=True) + NORM_EPS)
    return (y * g.astype(jnp.float32)).astype(x.dtype)


def layer_norm(x, g, b):
    xf = x.astype(jnp.float32)
    xc = xf - jnp.mean(xf, axis=-1, keepdims=True)
    y = xc * lax.rsqrt(jnp.mean(xc * xc, axis=-1, keepdims=True) + NORM_EPS)
    return (y * g.astype(jnp.float32) + b.astype(jnp.float32)).astype(x.dtype)


def chunk_gmlp(x, w_in, ln_g, ln_b, w_s, b_s, w_out):
    n, L, _ = x.shape
    z = jax.nn.gelu(x @ w_in, approximate=False)
    u, v = jnp.split(z, 2, axis=-1)
    v = layer_norm(v, ln_g, ln_b)
    pad = (-L) % CHUNK
    nc = (L + pad) // CHUNK
    vc = jnp.pad(v, ((0, 0), (0, pad), (0, 0))).reshape(n, nc, CHUNK, N_GROUPS, GROUP_DIM)
    causal = jnp.tril(jnp.ones((CHUNK, CHUNK), dtype=bool))
    w_causal = jnp.where(causal, w_s, 0.0)
    s = jnp.einsum("gts,ncsgd->nctgd", w_causal, vc) + b_s.T[:, :, None]
    s = s.reshape(n, nc * CHUNK, D_GMLP)[:, :L]
    y = (u * s) @ w_out
    start = ((L - 1) // CHUNK) * CHUNK
    return y, v[:, start:]


def qkv_project(x, w_qkv, b_qkv):
    n, L, _ = x.shape
    qkv = x @ w_qkv + b_qkv
    q, k, v = jnp.split(qkv, [N_HEADS * HEAD_DIM, (N_HEADS + N_KV_HEADS) * HEAD_DIM], axis=-1)
    return (q.reshape(n, L, N_KV_HEADS, Q_PER_KV, HEAD_DIM),
            k.reshape(n, L, N_KV_HEADS, HEAD_DIM),
            v.reshape(n, L, N_KV_HEADS, HEAD_DIM))


def sink_softmax_attention(q, k, v, mask, sinks):
    s = jnp.einsum("...qhgd,...khd->...hgqk", q, k, preferred_element_type=jnp.float32) * ATTN_SCALE
    s = jnp.where(mask, s, -jnp.inf)
    sink = sinks.astype(jnp.float32).reshape(N_KV_HEADS, Q_PER_KV, 1, 1)
    m = jnp.maximum(jnp.max(s, axis=-1, keepdims=True), sink)
    p = jnp.exp(s - m)
    p = p / (jnp.sum(p, axis=-1, keepdims=True) + jnp.exp(sink - m))
    return jnp.einsum("...hgqk,...khd->...qhgd", p.astype(v.dtype), v)


def swa_prompt(x, w_qkv, b_qkv, sinks, w_o, b_o):
    n, L, _ = x.shape
    q, k, v = qkv_project(x, w_qkv, b_qkv)
    nb = L // BLOCK
    qb = q.reshape(n, nb, BLOCK, N_KV_HEADS, Q_PER_KV, HEAD_DIM)
    kb = k.reshape(n, nb, BLOCK, N_KV_HEADS, HEAD_DIM)
    vb = v.reshape(n, nb, BLOCK, N_KV_HEADS, HEAD_DIM)

    def with_prev(t):
        prev = jnp.pad(t, ((0, 0), (1, 0), (0, 0), (0, 0), (0, 0)))[:, :-1]
        return jnp.concatenate([prev, t], axis=2)

    i = jnp.arange(BLOCK)[:, None]
    j = jnp.arange(2 * BLOCK)[None, :]
    diff = BLOCK + i - j
    kpos = (jnp.arange(nb)[:, None, None] - 1) * BLOCK + j
    mask = ((diff >= 0) & (diff <= WINDOW) & (kpos >= 0))[:, None, None]
    o = sink_softmax_attention(qb, with_prev(kb), with_prev(vb), mask, sinks)
    y = o.reshape(n, L, N_HEADS * HEAD_DIM) @ w_o + b_o
    return y, k[:, L - WINDOW:], v[:, L - WINDOW:]


def swa_sample(x, win_k, win_v, w_qkv, b_qkv, sinks, w_o, b_o):
    n, T, _ = x.shape
    q, k, v = qkv_project(x, w_qkv, b_qkv)
    kk = jnp.concatenate([win_k.astype(k.dtype), k], axis=1)
    vv = jnp.concatenate([win_v.astype(v.dtype), v], axis=1)
    i = jnp.arange(T)[:, None]
    j = jnp.arange(WINDOW + T)[None, :]
    diff = i + WINDOW - j
    mask = (diff >= 0) & (diff <= WINDOW)
    o = sink_softmax_attention(q, kk, vv, mask, sinks)
    y = o.reshape(n, T, N_HEADS * HEAD_DIM) @ w_o + b_o
    return y, kk[:, T:], vv[:, T:]


def conv_ffn(x, prev, w_up, conv_w, conv_b, w_down):
    L = x.shape[1]
    h = x @ w_up
    hp = jnp.concatenate([prev.astype(h.dtype), h], axis=1)
    c = conv_b
    for t in range(CONV_W):
        c = c + conv_w[t] * hp[:, t:t + L]
    gate, val = jnp.split(c, 2, axis=-1)
    return (jax.nn.silu(gate) * val) @ w_down, hp[:, L:]


def setup_inputs(seed: int = 0) -> dict:
    key = jax.random.key(seed)
    ks = iter(jax.random.split(key, 32))

    def nrm(shape, scale):
        return jax.random.normal(next(ks), shape, jnp.float32) * scale

    def gain(shape):
        return 1.0 + nrm(shape, 0.02)

    qkv_width = (N_HEADS + 2 * N_KV_HEADS) * HEAD_DIM
    return {
        "x_prompt": nrm((BATCH, SEQ, D_MODEL), 1.0),
        "x_sample": nrm((DEC_BATCH, DEC_SEQ, D_MODEL), 1.0),
        "cache_win_k": nrm((N_SWA_LAYERS, DEC_BATCH, WINDOW, N_KV_HEADS, HEAD_DIM), 1.0),
        "cache_win_v": nrm((N_SWA_LAYERS, DEC_BATCH, WINDOW, N_KV_HEADS, HEAD_DIM), 1.0),
        "state_conv": nrm((DEPTH, DEC_BATCH, CONV_W - 1, 2 * D_FF), 1.0),
        "norm_mix_pre": gain((DEPTH, D_MODEL)),
        "norm_mix_post": gain((DEPTH, D_MODEL)),
        "norm_ffn_pre": gain((DEPTH, D_MODEL)),
        "norm_ffn_post": gain((DEPTH, D_MODEL)),
        "gmlp_w_in": nrm((N_GMLP_LAYERS, D_MODEL, 2 * D_GMLP), D_MODEL ** -0.5),
        "gmlp_ln_g": gain((N_GMLP_LAYERS, D_GMLP)),
        "gmlp_ln_b": nrm((N_GMLP_LAYERS, D_GMLP), 0.02),
        "gmlp_w_s": nrm((N_GMLP_LAYERS, N_GROUPS, CHUNK, CHUNK), CHUNK ** -0.5),
        "gmlp_b_s": 1.0 + nrm((N_GMLP_LAYERS, N_GROUPS, CHUNK), 0.1),
        "gmlp_w_out": nrm((N_GMLP_LAYERS, D_GMLP, D_MODEL), D_GMLP ** -0.5),
        "attn_w_qkv": nrm((N_SWA_LAYERS, D_MODEL, qkv_width), D_MODEL ** -0.5),
        "attn_b_qkv": nrm((N_SWA_LAYERS, qkv_width), 0.02),
        "attn_sinks": nrm((N_SWA_LAYERS, N_HEADS), 1.0),
        "attn_w_o": nrm((N_SWA_LAYERS, N_HEADS * HEAD_DIM, D_MODEL), (N_HEADS * HEAD_DIM) ** -0.5),
        "attn_b_o": nrm((N_SWA_LAYERS, D_MODEL), 0.02),
        "ffn_w_up": nrm((DEPTH, D_MODEL, 2 * D_FF), D_MODEL ** -0.5),
        "ffn_conv_w": nrm((DEPTH, CONV_W, 2 * D_FF), CONV_W ** -0.5),
        "ffn_conv_b": nrm((DEPTH, 2 * D_FF), 0.02),
        "ffn_w_down": nrm((DEPTH, D_FF, D_MODEL), D_FF ** -0.5),
    }


def reference(x_prompt, x_sample, cache_win_k, cache_win_v, state_conv,
              norm_mix_pre, norm_mix_post, norm_ffn_pre, norm_ffn_post,
              gmlp_w_in, gmlp_ln_g, gmlp_ln_b, gmlp_w_s, gmlp_b_s, gmlp_w_out,
              attn_w_qkv, attn_b_qkv, attn_sinks, attn_w_o, attn_b_o,
              ffn_w_up, ffn_conv_w, ffn_conv_b, ffn_w_down):
    xp, xs = x_prompt, x_sample
    gv_p, gv_s, wk_p, wv_p, wk_s, wv_s, cv_p, cv_s = [], [], [], [], [], [], [], []
    for layer in range(DEPTH):
        idx = layer // N_MIXERS
        hp = rms_norm(xp, norm_mix_pre[layer])
        hs = rms_norm(xs, norm_mix_pre[layer])
        if layer % N_MIXERS == 0:
            mp, g_p = chunk_gmlp(hp, gmlp_w_in[idx], gmlp_ln_g[idx], gmlp_ln_b[idx],
                                 gmlp_w_s[idx], gmlp_b_s[idx], gmlp_w_out[idx])
            ms, g_s = chunk_gmlp(hs, gmlp_w_in[idx], gmlp_ln_g[idx], gmlp_ln_b[idx],
                                 gmlp_w_s[idx], gmlp_b_s[idx], gmlp_w_out[idx])
            gv_p.append(g_p)
            gv_s.append(g_s)
        else:
            mp, k_p, v_p = swa_prompt(hp, attn_w_qkv[idx], attn_b_qkv[idx], attn_sinks[idx],
                                      attn_w_o[idx], attn_b_o[idx])
            ms, k_s, v_s = swa_sample(hs, cache_win_k[idx], cache_win_v[idx], attn_w_qkv[idx],
                                      attn_b_qkv[idx], attn_sinks[idx], attn_w_o[idx], attn_b_o[idx])
            wk_p.append(k_p)
            wv_p.append(v_p)
            wk_s.append(k_s)
            wv_s.append(v_s)
        xp = xp + rms_norm(mp, norm_mix_post[layer])
        xs = xs + rms_norm(ms, norm_mix_post[layer])

        zero_prev = jnp.zeros((xp.shape[0], CONV_W - 1, 2 * D_FF), xp.dtype)
        fp, c_p = conv_ffn(rms_norm(xp, norm_ffn_pre[layer]), zero_prev, ffn_w_up[layer],
                           ffn_conv_w[layer], ffn_conv_b[layer], ffn_w_down[layer])
        fs, c_s = conv_ffn(rms_norm(xs, norm_ffn_pre[layer]), state_conv[layer], ffn_w_up[layer],
                           ffn_conv_w[layer], ffn_conv_b[layer], ffn_w_down[layer])
        cv_p.append(c_p)
        cv_s.append(c_s)
        xp = xp + rms_norm(fp, norm_ffn_post[layer])
        xs = xs + rms_norm(fs, norm_ffn_post[layer])
    return (xp, xs, jnp.stack(gv_p), jnp.stack(gv_s), jnp.stack(wk_p), jnp.stack(wv_p),
            jnp.stack(wk_s), jnp.stack(wv_s), jnp.stack(cv_p), jnp.stack(cv_s))
```

```cpp
#include <hip/hip_runtime.h>
#include <cstdio>
#include <cstdint>
namespace pg8 {
#define PG8_LAS __attribute__((address_space(3)))
typedef unsigned short bf16_t;
typedef short bf16x8 __attribute__((ext_vector_type(8)));
typedef float f32x4 __attribute__((ext_vector_type(4)));
typedef unsigned u32x4 __attribute__((ext_vector_type(4)));
constexpr int BM = 256, BK = 64, HALF = 128, HTB = HALF * BK * 2  , STAGE_BYTES = 8 * HTB, NXCD = 8, WGM = 8;

__host__ __device__ __forceinline__ int lds_byte(int r, int c) { const int st = (r >> 4) * 2 + (c >> 5), rr = r & 15, cc = c & 31, ob = rr * 64 + cc * 2; return st * 1024 + (ob ^ (((ob >> 9) & 1) << 5)); }
__host__ __device__ __forceinline__ void stage_rc(int b, int& R, int& C) { const int st = b / 1024, sb = b % 1024, swz = sb ^ (((sb >> 9) & 1) << 5); R = (st >> 1) * 16 + swz / 64; C = (st & 1) * 32 + (swz % 64) / 2; }
__host__ __device__ __forceinline__ int perm32(int rho) { const int n = rho >> 4, i = rho & 15; return 8 * (i >> 2) + 4 * n + (i & 3); }

struct Unit { int pm, pn; };
struct Gemm { const bf16_t* A; const bf16_t* Bt; int M, N, K; };

struct StaticOrder {
    int nM, nN, nwg, G, c;
    __host__ __device__ void init(int M, int N, int G_, int c_) { nM = M / BM; nN = N / BM; nwg = nM * nN; G = G_; c = c_; }
    __host__ __device__ bool next(int i, Unit& u) const {
        const long L = (long)i * G + c; if (L >= nwg) return false;
        int wgid = (int)L; { const int q = nwg / NXCD, r = nwg % NXCD, xcd = wgid % NXCD, off = wgid / NXCD; wgid = (xcd < r ? xcd * (q + 1) : r * (q + 1) + (xcd - r) * q) + off; }
        const int nig = WGM * nN, gid = wgid / nig, fm = gid * WGM, gsz = (nM - fm) < WGM ? (nM - fm) : WGM;
        u.pm = fm + ((wgid % nig) % gsz); u.pn = (wgid % nig) / gsz; return true;
    }
    __device__ __forceinline__ void a_ready(const Unit&) const {}
    __device__ __forceinline__ void done(const Unit&) const {}
};

__device__ __forceinline__ unsigned cvt_pk_bf16(float lo, float hi) { unsigned r; asm volatile("v_cvt_pk_bf16_f32 %0, %1, %2" : "=v"(r) : "v"(lo), "v"(hi)); return r; }
typedef float f32x2 __attribute__((ext_vector_type(2)));
__device__ __forceinline__ f32x2 gelu_pk(f32x2 v) {
    const f32x2 av = __builtin_elementwise_abs(v), d = av * 0.2316418882f + 1.0f;
    f32x2 t; t.x = __builtin_amdgcn_rcpf(d.x); t.y = __builtin_amdgcn_rcpf(d.y);
    f32x2 q = t * 0.5307027145f + (-0.7265760135f); q = q * t + 0.7107068705f; q = q * t + (-0.142248368f); q = q * t + 0.127414796f; q = q * t;
    const f32x2 s = (v * v) * (-0.72134752044f);
    f32x2 e; e.x = __builtin_amdgcn_exp2f(s.x); e.y = __builtin_amdgcn_exp2f(s.y);
    const f32x2 m = v * (q * e), r = v - m;
    f32x2 o; o.x = v.x < 0.f ? m.x : r.x; o.y = v.y < 0.f ? m.y : r.y; return o;
}


struct EpiF32 {
    static constexpr bool PERM = false, AFTER_DRAIN = false;
    float* C; int ldc; const float* bias;
    __device__ __forceinline__ void operator()(const f32x4 (&acc)[2][2][4][2], const Unit& u, int wr, int wc, int fr, int fq) const {
        const int row0 = u.pm * BM + wr * 64 + fr, col0 = u.pn * BM + wc * 32 + 4 * fq;
        f32x4 bv[2][2];
#pragma unroll
        for (int bj = 0; bj < 2; ++bj)
#pragma unroll
            for (int n = 0; n < 2; ++n) bv[bj][n] = bias ? *(const f32x4*)(bias + col0 + bj * HALF + n * 16) : (f32x4){0.f, 0.f, 0.f, 0.f};
#pragma unroll
        for (int ai = 0; ai < 2; ++ai)
#pragma unroll
            for (int m = 0; m < 4; ++m) { float* rowp = C + (size_t)(row0 + ai * HALF + m * 16) * ldc + col0;
#pragma unroll
                for (int bj = 0; bj < 2; ++bj)
#pragma unroll
                    for (int n = 0; n < 2; ++n) *(f32x4*)(rowp + bj * HALF + n * 16) = acc[ai][bj][m][n] + bv[bj][n]; }
    }
};
struct EpiGeluUV {
    static constexpr bool PERM = true, AFTER_DRAIN = false;
    bf16_t* U; bf16_t* V; float* vstat;
    __device__ __forceinline__ void operator()(const f32x4 (&acc)[2][2][4][2], const Unit& u, int wr, int wc, int fr, int fq) const {
        const bool isv = u.pn >= 16;
        const int row0 = u.pm * BM + wr * 64 + fr, col0 = (u.pn & 15) * BM + wc * 32 + 8 * fq;
        bf16_t* base = isv ? V : U;
#pragma unroll
        for (int ai = 0; ai < 2; ++ai)
#pragma unroll
            for (int m = 0; m < 4; ++m) { const int row = row0 + ai * HALF + m * 16; bf16_t* rowp = base + (size_t)row * 4096 + col0; float s = 0.f, q = 0.f;
#pragma unroll
                for (int bj = 0; bj < 2; ++bj) { f32x4 v0 = acc[ai][bj][m][0], v1 = acc[ai][bj][m][1];
                    { f32x2 a = gelu_pk((f32x2){v0[0], v0[1]}), b = gelu_pk((f32x2){v0[2], v0[3]}), c = gelu_pk((f32x2){v1[0], v1[1]}), d = gelu_pk((f32x2){v1[2], v1[3]});
                      v0 = (f32x4){a.x, a.y, b.x, b.y}; v1 = (f32x4){c.x, c.y, d.x, d.y}; }
                    s += ((v0[0] + v0[1]) + (v0[2] + v0[3])) + ((v1[0] + v1[1]) + (v1[2] + v1[3]));
                    q += ((v0[0] * v0[0] + v0[1] * v0[1]) + (v0[2] * v0[2] + v0[3] * v0[3])) + ((v1[0] * v1[0] + v1[1] * v1[1]) + (v1[2] * v1[2] + v1[3] * v1[3]));
                    u32x4 w; w.x = cvt_pk_bf16(v0[0], v0[1]); w.y = cvt_pk_bf16(v0[2], v0[3]); w.z = cvt_pk_bf16(v1[0], v1[1]); w.w = cvt_pk_bf16(v1[2], v1[3]);
                    *(u32x4*)(rowp + bj * HALF) = w; }
                if (isv) { s += __shfl_xor(s, 16); s += __shfl_xor(s, 32); q += __shfl_xor(q, 16); q += __shfl_xor(q, 32);
                    if (fq == 0) *(f32x2*)(vstat + ((size_t)row * 64 + (u.pn - 16) * 4 + wc) * 2) = (f32x2){s, q}; } }
    }
};
struct EpiUp {
    static constexpr bool PERM = true, AFTER_DRAIN = false;
    bf16_t* H; float* cvp;
    __device__ __forceinline__ void operator()(const f32x4 (&acc)[2][2][4][2], const Unit& u, int wr, int wc, int fr, int fq) const {
        const int row0 = u.pm * BM + wr * 64 + fr, col0 = u.pn * BM + wc * 32 + 8 * fq;
#pragma unroll
        for (int ai = 0; ai < 2; ++ai)
#pragma unroll
            for (int m = 0; m < 4; ++m) { bf16_t* rowp = H + (size_t)(row0 + ai * HALF + m * 16) * 22016 + col0;
#pragma unroll
                for (int bj = 0; bj < 2; ++bj) { const f32x4 v0 = acc[ai][bj][m][0], v1 = acc[ai][bj][m][1];
                    u32x4 w; w.x = cvt_pk_bf16(v0[0], v0[1]); w.y = cvt_pk_bf16(v0[2], v0[3]); w.z = cvt_pk_bf16(v1[0], v1[1]); w.w = cvt_pk_bf16(v1[2], v1[3]);
                    *(u32x4*)(rowp + bj * HALF) = w; } }
        if ((u.pm & 7) == 7 && wr == 1 && fr >= 14) {
            float* dst = cvp + (size_t)((u.pm >> 3) * 2 + (fr - 14)) * 22016 + col0;
#pragma unroll
            for (int bj = 0; bj < 2; ++bj)
#pragma unroll
                for (int n = 0; n < 2; ++n) *(f32x4*)(dst + bj * HALF + 4 * n) = acc[1][bj][3][n];
        }
    }
};
struct EpiQkv {
    static constexpr bool PERM = true, AFTER_DRAIN = false;
    bf16_t* QKV; const float* bias; float* wk; float* wv;
    __device__ __forceinline__ void operator()(const f32x4 (&acc)[2][2][4][2], const Unit& u, int wr, int wc, int fr, int fq) const {
        const int row0 = u.pm * BM + wr * 64 + fr, col0 = u.pn * BM + wc * 32 + 8 * fq;
        const bool win = ((u.pm & 7) == 7) && (u.pn >= 16);
        f32x4 bv[2][2];
#pragma unroll
        for (int bj = 0; bj < 2; ++bj)
#pragma unroll
            for (int n = 0; n < 2; ++n) bv[bj][n] = *(const f32x4*)(bias + col0 + bj * HALF + 4 * n);
#pragma unroll
        for (int ai = 0; ai < 2; ++ai)
#pragma unroll
            for (int m = 0; m < 4; ++m) { bf16_t* rowp = QKV + (size_t)(row0 + ai * HALF + m * 16) * 5120 + col0;
#pragma unroll
                for (int bj = 0; bj < 2; ++bj) { const f32x4 v0 = acc[ai][bj][m][0] + bv[bj][0], v1 = acc[ai][bj][m][1] + bv[bj][1];
                    u32x4 w; w.x = cvt_pk_bf16(v0[0], v0[1]); w.y = cvt_pk_bf16(v0[2], v0[3]); w.z = cvt_pk_bf16(v1[0], v1[1]); w.w = cvt_pk_bf16(v1[2], v1[3]);
                    *(u32x4*)(rowp + bj * HALF) = w;
                    if (win && ai == 1) { float* dst = (u.pn >= 18 ? wv : wk) + (size_t)((u.pm >> 3) * 128 + wr * 64 + m * 16 + fr) * 512 + ((u.pn - 16) & 1) * 256 + wc * 32 + 8 * fq + bj * HALF;
                        *(f32x4*)dst = v0; *(f32x4*)(dst + 4) = v1; } } }
    }
};
template <class Epi, class Sched, bool ALIGN_EPI = false, bool SP2 = false>
__device__ __forceinline__ void gemm_phase(PG8_LAS unsigned char* lds, const Gemm g, const Sched& S, const Epi& E) {
    int tid_l = threadIdx.x; asm volatile("" : "+v"(tid_l));
    const int tid = tid_l, wid = __builtin_amdgcn_readfirstlane(tid >> 6), lane = tid & 63, wr = wid >> 2, wc = wid & 3, fr = lane & 15, fq = lane >> 4;
    const int K = g.K, nt = K / BK;
    unsigned voffA[2], voffB[2];
#pragma unroll
    for (int i = 0; i < 2; ++i) { int R, C; stage_rc(tid * 16 + i * 8192, R, C); const int Rb = Epi::PERM ? ((R & ~31) + perm32(R & 31)) : R;
        voffA[i] = (unsigned)(R * K + C) * 2u; voffB[i] = (unsigned)(Rb * K + C) * 2u; }
    const size_t kstep = (size_t)(BK * 2);
    const size_t hstep = (size_t)HALF * K * 2;
    const size_t tstep = 2 * hstep;
    const unsigned ldsw = (unsigned)wid * 1024u;
    const int aoff = lds_byte(wr * 64 + fr, fq * 8), boff = lds_byte(wc * 32 + fr, fq * 8);
#define PG8_SA(b, h) (((b) * 2 + (h)) * HTB)
#define PG8_SB(b, h) ((4 + (b) * 2 + (h)) * HTB)
#define PG8_STAGE(bufoff, gbase, voff) do { _Pragma("unroll") for (int _i = 0; _i < 2; ++_i) \
        __builtin_amdgcn_global_load_lds((const unsigned*)((const char*)(gbase) + (voff)[_i]), (PG8_LAS unsigned*)(lds + (bufoff) + ldsw + _i * 8192), 16, 0, 0); } while (0)
#define PG8_LDA(dst, b, h) do { _Pragma("unroll") for (int m = 0; m < 4; ++m) _Pragma("unroll") for (int k = 0; k < 2; ++k) dst[m][k] = *(const PG8_LAS bf16x8*)(lds + PG8_SA(b, h) + aoff + m * 2048 + k * 1024); } while (0)
#define PG8_LDB(dst, b, h) do { _Pragma("unroll") for (int n = 0; n < 2; ++n) _Pragma("unroll") for (int k = 0; k < 2; ++k) dst[n][k] = *(const PG8_LAS bf16x8*)(lds + PG8_SB(b, h) + boff + n * 2048 + k * 1024); } while (0)
#define PG8_MMA(ai, bj, At, Bt) do { __builtin_amdgcn_s_setprio(1); _Pragma("unroll") for (int m = 0; m < 4; ++m) _Pragma("unroll") for (int n = 0; n < 2; ++n) _Pragma("unroll") for (int k = 0; k < 2; ++k) \
        acc[ai][bj][m][n] = __builtin_amdgcn_mfma_f32_16x16x32_bf16(Bt[n][k], At[m][k], acc[ai][bj][m][n], 0, 0, 0); __builtin_amdgcn_s_setprio(0); } while (0)
#define PG8_WAIT_V(n) asm volatile("s_waitcnt vmcnt(" #n ")" ::: "memory")
#define PG8_WAIT_L(n) asm volatile("s_waitcnt lgkmcnt(" #n ")" ::: "memory")
#define PG8_BAR __builtin_amdgcn_s_barrier()
#define PG8_SCHED __builtin_amdgcn_sched_barrier(0)
    Unit cur, nxt; int ui = 0;
    if (!S.next(0, cur)) return;
    f32x4 acc[2][2][4][2];
#pragma unroll
    for (int a = 0; a < 2; ++a)
#pragma unroll
        for (int b = 0; b < 2; ++b)
#pragma unroll
            for (int m = 0; m < 4; ++m)
#pragma unroll
                for (int n = 0; n < 2; ++n) acc[a][b][m][n] = (f32x4){0.f, 0.f, 0.f, 0.f};
    bf16x8 At[4][2], B0[2][2], B1[2][2];
    const char* cA = (const char*)g.A + (size_t)cur.pm * tstep; const char* cB = (const char*)g.Bt + (size_t)cur.pn * tstep;
    S.a_ready(cur);
    if constexpr (SP2) {
        PG8_STAGE(PG8_SB(0, 0), cB, voffB); PG8_STAGE(PG8_SB(0, 1), cB + hstep, voffB); PG8_STAGE(PG8_SA(0, 0), cA, voffA); PG8_STAGE(PG8_SA(0, 1), cA + hstep, voffA);
        if (wr == 1) PG8_BAR;
        PG8_WAIT_V(2); PG8_BAR;
        PG8_STAGE(PG8_SB(1, 0), cB + kstep, voffB); PG8_STAGE(PG8_SA(1, 0), cA + kstep, voffA); PG8_STAGE(PG8_SB(1, 1), cB + hstep + kstep, voffB);
        PG8_WAIT_V(6); PG8_BAR;
    } else {
        PG8_STAGE(PG8_SB(0, 0), cB, voffB); PG8_STAGE(PG8_SA(0, 0), cA, voffA); PG8_STAGE(PG8_SB(0, 1), cB + hstep, voffB); PG8_STAGE(PG8_SA(0, 1), cA + hstep, voffA);
        if (wr == 1) PG8_BAR;
        PG8_WAIT_V(4); PG8_BAR;
        PG8_STAGE(PG8_SB(1, 0), cB + kstep, voffB); PG8_STAGE(PG8_SA(1, 0), cA + kstep, voffA); PG8_STAGE(PG8_SB(1, 1), cB + hstep + kstep, voffB);
        PG8_WAIT_V(6); PG8_BAR;
    }
    for (;;) {
        const bool has_next = S.next(ui + 1, nxt);
        const char* nA = has_next ? (const char*)g.A + (size_t)nxt.pm * tstep : cA; const char* nB = has_next ? (const char*)g.Bt + (size_t)nxt.pn * tstep : cB;
        for (int t = 0; t < nt; t += 2) {
            const bool last = (t == nt - 2);
            const char* a1 = cA + (size_t)(t + 1) * kstep;
            const char* a2 = last ? nA : cA + (size_t)(t + 2) * kstep; const char* b2 = last ? nB : cB + (size_t)(t + 2) * kstep;
            const char* a3 = a2 + kstep; const char* b3 = b2 + kstep;
            if (last && has_next) S.a_ready(nxt);
            if constexpr (SP2) {
            PG8_LDB(B0, 0, 0); PG8_LDB(B1, 0, 1); PG8_SCHED; PG8_LDA(At, 0, 0); PG8_STAGE(PG8_SA(1, 1), a1 + hstep, voffA);
            PG8_WAIT_V(8); PG8_WAIT_L(0); PG8_BAR; PG8_MMA(0, 0, At, B0); PG8_MMA(0, 1, At, B1); PG8_BAR; PG8_SCHED;
            PG8_LDA(At, 0, 1); PG8_STAGE(PG8_SB(0, 0), b2, voffB); PG8_STAGE(PG8_SB(0, 1), b2 + hstep, voffB); PG8_STAGE(PG8_SA(0, 0), a2, voffA);
            PG8_WAIT_V(8); PG8_WAIT_L(0); PG8_BAR; PG8_MMA(1, 0, At, B0); PG8_MMA(1, 1, At, B1); PG8_BAR; PG8_SCHED;
            PG8_LDB(B0, 1, 0); PG8_LDB(B1, 1, 1); PG8_SCHED; PG8_LDA(At, 1, 0); PG8_STAGE(PG8_SA(0, 1), a2 + hstep, voffA);
            PG8_WAIT_V(8); PG8_WAIT_L(0); PG8_BAR; PG8_MMA(0, 0, At, B0); PG8_MMA(0, 1, At, B1); PG8_BAR; PG8_SCHED;
            PG8_LDA(At, 1, 1); PG8_STAGE(PG8_SB(1, 0), b3, voffB); PG8_STAGE(PG8_SB(1, 1), b3 + hstep, voffB); PG8_STAGE(PG8_SA(1, 0), a3, voffA);
            PG8_WAIT_V(8); PG8_WAIT_L(0); PG8_BAR; PG8_MMA(1, 0, At, B0); PG8_MMA(1, 1, At, B1); PG8_BAR; PG8_SCHED;
            } else {
            PG8_LDB(B0, 0, 0); PG8_SCHED; PG8_LDA(At, 0, 0); PG8_STAGE(PG8_SA(1, 1), a1 + hstep, voffA);
            PG8_WAIT_L(8); PG8_BAR; PG8_WAIT_L(0); PG8_MMA(0, 0, At, B0); PG8_BAR; PG8_SCHED;
            PG8_LDB(B1, 0, 1); PG8_STAGE(PG8_SB(0, 0), b2, voffB);
            PG8_BAR; PG8_WAIT_L(0); PG8_MMA(0, 1, At, B1); PG8_BAR;
            PG8_LDA(At, 0, 1); PG8_STAGE(PG8_SA(0, 0), a2, voffA);
            PG8_BAR; PG8_WAIT_L(0); PG8_MMA(1, 0, At, B0); PG8_BAR; PG8_SCHED;
            PG8_STAGE(PG8_SB(0, 1), b2 + hstep, voffB);
            PG8_WAIT_V(6); PG8_BAR; PG8_MMA(1, 1, At, B1); PG8_BAR;
            PG8_LDB(B0, 1, 0); PG8_SCHED; PG8_LDA(At, 1, 0); PG8_STAGE(PG8_SA(0, 1), a2 + hstep, voffA);
            PG8_WAIT_L(8); PG8_BAR; PG8_WAIT_L(0); PG8_MMA(0, 0, At, B0); PG8_BAR; PG8_SCHED;
            PG8_LDB(B1, 1, 1); PG8_STAGE(PG8_SB(1, 0), b3, voffB);
            PG8_BAR; PG8_WAIT_L(0); PG8_MMA(0, 1, At, B1); PG8_BAR;
            PG8_LDA(At, 1, 1); PG8_STAGE(PG8_SA(1, 0), a3, voffA);
            PG8_BAR; PG8_WAIT_L(0); PG8_MMA(1, 0, At, B0); PG8_BAR; PG8_SCHED;
            PG8_STAGE(PG8_SB(1, 1), b3 + hstep, voffB);
            PG8_WAIT_V(6); PG8_BAR; PG8_MMA(1, 1, At, B1); PG8_BAR;
            }
        }
        if constexpr (ALIGN_EPI) { if (wr == 0) PG8_BAR; }
        if constexpr (!Epi::AFTER_DRAIN) { E(acc, cur, wr, wc, fr, fq); S.done(cur); }
        if (!has_next) break;
#pragma unroll
        for (int a = 0; a < 2; ++a)
#pragma unroll
            for (int b = 0; b < 2; ++b)
#pragma unroll
                for (int m = 0; m < 4; ++m)
#pragma unroll
                    for (int n = 0; n < 2; ++n) acc[a][b][m][n] = (f32x4){0.f, 0.f, 0.f, 0.f};
        cur = nxt; cA = nA; cB = nB; ++ui;
        if constexpr (ALIGN_EPI) { if (wr == 1) PG8_BAR; }
    }
    PG8_WAIT_V(0);
    if constexpr (!ALIGN_EPI) { if (wr == 0) PG8_BAR; }
    PG8_BAR;
    if constexpr (Epi::AFTER_DRAIN) { E.fused(acc, cur, wr, wc, fr, fq, lds, wid, lane); S.done(cur); }
#undef PG8_SA
#undef PG8_SB
#undef PG8_STAGE
#undef PG8_LDA
#undef PG8_LDB
#undef PG8_MMA
#undef PG8_WAIT_V
#undef PG8_WAIT_L
#undef PG8_BAR
#undef PG8_SCHED
}
}
#define GAS __attribute__((address_space(1)))
#define LAS __attribute__((address_space(3)))
typedef unsigned short bf16;
typedef unsigned v4u __attribute__((ext_vector_type(4)));
typedef float f32x4 __attribute__((ext_vector_type(4)));
typedef short bf16x8 __attribute__((ext_vector_type(8)));
typedef GAS unsigned gu32;
typedef GAS unsigned long long gu64;
#define RLX_AGENT __ATOMIC_RELAXED, __HIP_MEMORY_SCOPE_AGENT
#define LDS_WAIT() asm volatile("s_waitcnt lgkmcnt(0)" ::: "memory")
#define VM_WAIT() asm volatile("s_waitcnt vmcnt(0)" ::: "memory")
__device__ __forceinline__ unsigned long long rt() { return __builtin_amdgcn_s_memrealtime(); }
__device__ __forceinline__ unsigned f2bf(float f) { unsigned u = __builtin_bit_cast(unsigned, f); return (u + 0x7fffu + ((u >> 16) & 1u)) >> 16; }
__device__ __forceinline__ unsigned pk2(float lo, float hi) { return f2bf(lo) | (f2bf(hi) << 16); }

#define XB_TMO      128
#define XB_XCNT(j)  (256  + 64 * (j))
#define XB_XSUB(j)  (1280 + 64 * (j))
#define XB_XGEN(j)  (2304 + 64 * (j))
#define XB_TOP      3328
#define XB_TOPGEN   3392
#define XCD_BAR_WORDS 3456
#define XB_SPIN_CAP (1u << 18)

__device__ __forceinline__ unsigned xb_ld(unsigned* p)              { return __hip_atomic_load(p, __ATOMIC_RELAXED, __HIP_MEMORY_SCOPE_AGENT); }
__device__ __forceinline__ unsigned xb_add(unsigned* p, unsigned v) { return __hip_atomic_fetch_add(p, v, __ATOMIC_RELAXED, __HIP_MEMORY_SCOPE_AGENT); }
__device__ __forceinline__ unsigned xb_xcc_id() { return (unsigned)__builtin_amdgcn_s_getreg((3 << 11) | 20) & 0xFu; }
#define XB_SPIN(cond, bar) do { unsigned _sp = 0; while (cond) { __builtin_amdgcn_s_sleep(1); \
    if ((++_sp & 255u) == 0u) { if (xb_ld(&(bar)[XB_TMO])) break; if (_sp > XB_SPIN_CAP) { atomicAdd(&(bar)[XB_TMO], 1u); break; } } } } while (0)

struct XcdBarrier {
    unsigned* bar; unsigned x;
    volatile LAS unsigned* st;
};

__device__ __forceinline__ XcdBarrier xcd_barrier_post(unsigned* bar, volatile LAS unsigned* st) {
    XcdBarrier b; b.bar = bar; b.x = xb_xcc_id(); b.st = st;
    if (threadIdx.x == 0) (void)xb_add(&bar[XB_XCNT(b.x)], 1u);
    return b;
}
__device__ __forceinline__ void xcd_barrier_complete(unsigned* bar, unsigned x, unsigned& nloc, unsigned& nx) {
    const unsigned G = gridDim.x * gridDim.y * gridDim.z;
    unsigned sum, cnt, mine, sp = 0u;
    for (;;) {
        sum = 0u; cnt = 0u; mine = 0u;
#pragma unroll
        for (unsigned j = 0; j < 16; ++j) { const unsigned c = xb_ld(&bar[XB_XCNT(j)]); sum += c; cnt += (c > 0u) ? 1u : 0u; mine = (j == x) ? c : mine; }
        if (sum == G) break;
        __builtin_amdgcn_s_sleep(1);
        if ((++sp & 255u) == 0u) { if (xb_ld(&bar[XB_TMO])) break; if (sp > XB_SPIN_CAP) { atomicAdd(&bar[XB_TMO], 1u); break; } }
    }
    nloc = mine > 0u ? mine : 1u; nx = cnt > 0u ? cnt : 1u;
}

__device__ __forceinline__ void xcd_barrier(const XcdBarrier& b) {
    asm volatile("s_waitcnt vmcnt(0)" ::: "memory");
    __syncthreads();
    if (threadIdx.x == 0) {
        unsigned* bar = b.bar;
        __builtin_amdgcn_s_waitcnt(0);
        unsigned nloc = b.st[0], nx = b.st[1];
        if (nloc == 0u) { xcd_barrier_complete(bar, b.x, nloc, nx); b.st[0] = nloc; b.st[1] = nx; }
        const unsigned old = xb_add(&bar[XB_XSUB(b.x)], 1u);
        const unsigned gen = old / nloc;
        if (old + 1u == (gen + 1u) * nloc) {
            __builtin_amdgcn_fence(__ATOMIC_RELEASE, "agent");
            asm volatile("s_waitcnt vmcnt(0)" ::: "memory");
            const unsigned og = xb_add(&bar[XB_TOP], 1u);
            const unsigned tg = og / nx;
            if (og + 1u == (tg + 1u) * nx) xb_add(&bar[XB_TOPGEN], 1u);
            else XB_SPIN(xb_ld(&bar[XB_TOPGEN]) == tg, bar);
            __builtin_amdgcn_fence(__ATOMIC_ACQUIRE, "agent");
            xb_add(&bar[XB_XGEN(b.x)], 1u);
            asm volatile("s_waitcnt vmcnt(0)" ::: "memory");
        } else {
            XB_SPIN(xb_ld(&bar[XB_XGEN(b.x)]) == gen, bar);
            __builtin_amdgcn_fence(__ATOMIC_ACQUIRE, "agent");
            asm volatile("s_waitcnt vmcnt(0)" ::: "memory");
        }
    }
    __syncthreads();
}

constexpr int D = 4096, MP = 8192, MS = 32, SEQ = 2048, NBATCH = 4;
constexpr int DFF = 11008, DFF2 = 22016, NQKV = 5120, DZ = 8192;
constexpr float NORM_EPS = 1e-6f, ATTN_SCALE = 0.125f;
constexpr int NWAVES = 8;

enum { I_XP = 0, I_XS, I_CK, I_CV, I_SC, I_NMPRE, I_NMPOST, I_NFPRE, I_NFPOST, I_WIN, I_LNG, I_LNB, I_WS, I_BS, I_WOUT, I_WQKV, I_BQKV, I_SINK, I_WO, I_BO, I_WUP, I_CW, I_CB, I_WDN, N_IN };
constexpr size_t O_Y = 0, O_YS = O_Y + (size_t)MP * D, O_GVP = O_YS + (size_t)MS * D, O_GVS = O_GVP + (size_t)NBATCH * 128 * D, O_WKP = O_GVS + (size_t)MS * D,
                 O_WVP = O_WKP + (size_t)NBATCH * 128 * 512, O_WKS = O_WVP + (size_t)NBATCH * 128 * 512, O_WVS = O_WKS + (size_t)MS * 128 * 512, O_CVP = O_WVS + (size_t)MS * 128 * 512,
                 O_CVS = O_CVP + (size_t)2 * NBATCH * 2 * DFF2, O_END = O_CVS + (size_t)2 * MS * 2 * DFF2;
static_assert(O_END == 43802624, "output size");

constexpr size_t MiB = 1u << 20;
constexpr size_t WS_CTL = 0, CTL_ZERO_BYTES = 1 * MiB;
constexpr size_t WS_WIN = 1 * MiB;
constexpr size_t WS_WOUT = WS_WIN + 64 * MiB;
constexpr size_t WS_WQKV = WS_WOUT + 32 * MiB;
constexpr size_t WS_WO = WS_WQKV + 40 * MiB;
constexpr size_t WS_WUP = WS_WO + 32 * MiB;
constexpr size_t WS_WDN = WS_WUP + 2 * 172 * MiB;
constexpr size_t WS_HN = WS_WDN + 2 * 86 * MiB;
constexpr size_t WS_U = WS_HN + 64 * MiB;
constexpr size_t WS_V = WS_U + 64 * MiB;
constexpr size_t WS_VSTAT = WS_V + 64 * MiB;
constexpr size_t WS_GATED = WS_VSTAT + 4 * MiB;
constexpr size_t WS_Y = WS_GATED + 64 * MiB;
constexpr size_t WS_X = WS_Y + 128 * MiB;
constexpr size_t WS_H = WS_X + 128 * MiB;
constexpr size_t WS_ACT = WS_H + 344 * MiB;
constexpr size_t WS_QKV = WS_ACT + 172 * MiB;
constexpr size_t WS_SMP = WS_QKV + 80 * MiB;
constexpr size_t SM_HS = 0;
constexpr size_t SM_ZS = SM_HS + 256 * 1024;
constexpr size_t SM_GS = SM_ZS + 1024 * 1024;
constexpr size_t SM_YS = SM_GS + 256 * 1024;
constexpr size_t SM_XS = SM_YS + 512 * 1024;
constexpr size_t SM_HHS = SM_XS + 512 * 1024;
constexpr size_t SM_ACTS = SM_HHS + 3 * 1024 * 1024;
constexpr size_t SM_QKVS = SM_ACTS + 1024 * 1024;
constexpr size_t WS_END = WS_SMP + 8 * MiB;
static_assert(SM_QKVS + 32 * 5120 * 4 <= 8 * MiB, "sample buffers");
constexpr int CW_BAR = 4096;

constexpr int RING_OFF = 0, RING_BYTES = 131072;
constexpr int LDSCTL_OFF = RING_BYTES, MISC_OFF = LDSCTL_OFF + 320;
constexpr int LDS_BYTES = 147456;
static_assert(MISC_OFF + 128 <= LDS_BYTES, "LDS map");

typedef short v4i16_t __attribute__((ext_vector_type(4)));
typedef float f32x2g __attribute__((ext_vector_type(2)));
typedef unsigned u32x2g __attribute__((ext_vector_type(2)));
__device__ __forceinline__ float bflo(unsigned w) { return __uint_as_float(w << 16); }
__device__ __forceinline__ float bfhi(unsigned w) { return __uint_as_float(w & 0xffff0000u); }
__device__ __forceinline__ unsigned cvtpk(float lo, float hi) { return pg8::cvt_pk_bf16(lo, hi); }
__device__ __forceinline__ float wave_sum(float v) {
#pragma unroll
    for (int o = 1; o < 64; o <<= 1) v += __shfl_xor(v, o);
    return v;
}
__device__ __forceinline__ v4i16_t ldtr(LAS const unsigned char* p) { return __builtin_amdgcn_ds_read_tr16_b64_v4i16((LAS v4i16_t*)p); }
__device__ __forceinline__ bf16x8 cat8(v4i16_t a, v4i16_t b) { return (bf16x8){a[0], a[1], a[2], a[3], b[0], b[1], b[2], b[3]}; }
__device__ __forceinline__ float gelu1(float x) { const pg8::f32x2 r = pg8::gelu_pk((pg8::f32x2){x, x}); return r.x; }
__device__ __forceinline__ float silu_mul(float g, float v) { return g * __builtin_amdgcn_rcpf(1.0f + __expf(-g)) * v; }

__device__ __forceinline__ void p0_transpose_item(const float* W, int K, int N, bf16* WT, LAS float* scr, int item, int lane) {
    const int nblk = N / 32, kb = item / nblk, nb = item % nblk, k0 = 64 * kb, n0 = 32 * nb;
#pragma unroll 8
    for (int i = 0; i < 32; ++i) { const int kk = 2 * i + (lane >> 5); scr[kk * 33 + (lane & 31)] = W[(size_t)(k0 + kk) * N + n0 + (lane & 31)]; }
    LDS_WAIT(); asm volatile("" ::: "memory");
    const int c = lane & 7;
#pragma unroll
    for (int j = 0; j < 4; ++j) { const int n = (lane >> 3) + 8 * j; const LAS float* s = scr + (8 * c) * 33 + n;
        v4u o; o.x = pk2(s[0 * 33], s[1 * 33]); o.y = pk2(s[2 * 33], s[3 * 33]); o.z = pk2(s[4 * 33], s[5 * 33]); o.w = pk2(s[6 * 33], s[7 * 33]);
        *(GAS v4u*)(WT + (size_t)(n0 + n) * K + k0 + 8 * c) = o; }
    LDS_WAIT(); asm volatile("" ::: "memory");
}

__device__ __forceinline__ void norm_row_bf16(const float* xrow, const float* g, bf16* orow, int lane) {
    const GAS f32x4* xr = (const GAS f32x4*)xrow + lane; const GAS f32x4* gr = (const GAS f32x4*)g + lane;
    f32x4 v[16]; float ss = 0.f;
#pragma unroll
    for (int j = 0; j < 16; ++j) { v[j] = xr[64 * j]; ss += (v[j].x * v[j].x + v[j].y * v[j].y) + (v[j].z * v[j].z + v[j].w * v[j].w); }
    const float r = 1.0f / sqrtf(wave_sum(ss) * (1.0f / D) + NORM_EPS);
    GAS u32x2g* o8 = (GAS u32x2g*)orow + lane;
#pragma unroll
    for (int j = 0; j < 16; ++j) { const f32x4 gg = gr[64 * j]; u32x2g w; w.x = cvtpk(v[j].x * r * gg.x, v[j].y * r * gg.y); w.y = cvtpk(v[j].z * r * gg.z, v[j].w * r * gg.w); o8[64 * j] = w; }
}
__device__ __forceinline__ void resid_norm_row(const float* yrow, const float* xin, const float* gpost, float* xout, const float* gpre, bf16* hn, int lane) {
    const GAS f32x4* yr = (const GAS f32x4*)yrow + lane; const GAS f32x4* xr = (const GAS f32x4*)xin + lane; const GAS f32x4* gp = (const GAS f32x4*)gpost + lane;
    f32x4 v[16]; float ss = 0.f;
#pragma unroll
    for (int j = 0; j < 16; ++j) { v[j] = yr[64 * j]; ss += (v[j].x * v[j].x + v[j].y * v[j].y) + (v[j].z * v[j].z + v[j].w * v[j].w); }
    const float r = 1.0f / sqrtf(wave_sum(ss) * (1.0f / D) + NORM_EPS);
    float s2 = 0.f; GAS f32x4* xo = (GAS f32x4*)xout + lane;
#pragma unroll
    for (int j = 0; j < 16; ++j) { const f32x4 gg = gp[64 * j]; const f32x4 xx = xr[64 * j]; v[j] = xx + v[j] * r * gg; xo[64 * j] = v[j];
        s2 += (v[j].x * v[j].x + v[j].y * v[j].y) + (v[j].z * v[j].z + v[j].w * v[j].w); }
    if (hn) {
        const float r2 = 1.0f / sqrtf(wave_sum(s2) * (1.0f / D) + NORM_EPS);
        const GAS f32x4* gq = (const GAS f32x4*)gpre + lane; GAS u32x2g* o8 = (GAS u32x2g*)hn + lane;
#pragma unroll
        for (int j = 0; j < 16; ++j) { const f32x4 gg = gq[64 * j]; u32x2g w; w.x = cvtpk(v[j].x * r2 * gg.x, v[j].y * r2 * gg.y); w.y = cvtpk(v[j].z * r2 * gg.z, v[j].w * r2 * gg.w); o8[64 * j] = w; }
    }
}

template <int NT, int ACT> __device__ __forceinline__ void skinny_gemm(LAS unsigned char* lds, const bf16* A, const bf16* Bt, int N, int K, float* out, int ldo, const float* bias, int cu, int G, int tid, int wave, int lane) {
    constexpr int CT = NT / 16;
    const int fr = lane & 15, fq = lane >> 4, kw = K / 8, k0 = wave * kw;
    LAS float* red = (LAS float*)lds;
    for (int tile = cu; tile < N / NT; tile += G) {
        const int n0 = tile * NT;
        f32x4 acc[2][CT];
#pragma unroll
        for (int r = 0; r < 2; ++r)
#pragma unroll
            for (int c = 0; c < CT; ++c) acc[r][c] = (f32x4){0.f, 0.f, 0.f, 0.f};
        const bf16* ap = A + (size_t)fr * K + k0 + 8 * fq; const bf16* bp = Bt + (size_t)(n0 + fr) * K + k0 + 8 * fq;
#pragma unroll 4
        for (int k = 0; k < kw; k += 32) {
            const bf16x8 a0 = *(const GAS bf16x8*)(ap + k), a1 = *(const GAS bf16x8*)(ap + (size_t)16 * K + k);
#pragma unroll
            for (int c = 0; c < CT; ++c) { const bf16x8 b = *(const GAS bf16x8*)(bp + (size_t)c * 16 * K + k);
                acc[0][c] = __builtin_amdgcn_mfma_f32_16x16x32_bf16(a0, b, acc[0][c], 0, 0, 0); acc[1][c] = __builtin_amdgcn_mfma_f32_16x16x32_bf16(a1, b, acc[1][c], 0, 0, 0); }
        }
#pragma unroll
        for (int r = 0; r < 2; ++r)
#pragma unroll
            for (int c = 0; c < CT; ++c)
#pragma unroll
                for (int i = 0; i < 4; ++i) red[(wave * 32 + 16 * r + 4 * fq + i) * NT + 16 * c + fr] = acc[r][c][i];
        __syncthreads();
        for (int e = tid; e < 32 * NT; e += NWAVES * 64) { float s = 0.f;
#pragma unroll
            for (int w = 0; w < 8; ++w) s += red[w * 32 * NT + e];
            const int row = e / NT, col = n0 + e % NT; if (bias) s += bias[col]; if (ACT == 1) s = gelu1(s); out[(size_t)row * ldo + col] = s; }
        __syncthreads();
    }
}

constexpr int GT_VS = 544, GT_WS = 272;
constexpr int GT_OFF_V = 0, GT_OFF_W = 128 * GT_VS, GT_OFF_MR = GT_OFF_W + 128 * GT_WS;
static_assert(GT_OFF_MR + 1024 <= RING_BYTES, "gating LDS");
__device__ __forceinline__ void gate_unit(LAS unsigned char* lds, int cidx, int g, const bf16* U, const bf16* V, const float* vstat, const float* ln_g, const float* ln_b,
                                          const float* w_s, const float* b_s, bf16* GATED, float* gvp, int tid, int wave, int lane) {
    const int t0 = cidx * 128, fr = lane & 15, fq = lane >> 4;
    LAS unsigned char* Vs = lds + GT_OFF_V; LAS unsigned char* Ws = lds + GT_OFF_W; LAS f32x2g* MR = (LAS f32x2g*)(lds + GT_OFF_MR);
    { const int tok = tid >> 2, qd = tid & 3; const GAS f32x4* p = (const GAS f32x4*)(vstat + ((size_t)(t0 + tok) * 64 + 16 * qd) * 2); float s = 0.f, q = 0.f;
#pragma unroll
      for (int j = 0; j < 8; ++j) { const f32x4 x = p[j]; s += x.x + x.z; q += x.y + x.w; }
      s += __shfl_xor(s, 1); s += __shfl_xor(s, 2); q += __shfl_xor(q, 1); q += __shfl_xor(q, 2);
      const float mean = s * (1.0f / D); const float var = fmaxf(q * (1.0f / D) - mean * mean, 0.f);
      if (qd == 0) MR[tok] = (f32x2g){mean, 1.0f / sqrtf(var + NORM_EPS)}; }
#pragma unroll
    for (int i = 0; i < 8; ++i) { const int idx = tid + 512 * i, t = idx >> 5, s4 = (idx & 31) * 4; const f32x4 w = *(const GAS f32x4*)(w_s + ((size_t)g * 128 + t) * 128 + s4);
        u32x2g o; o.x = cvtpk(s4 + 0 <= t ? w.x : 0.f, s4 + 1 <= t ? w.y : 0.f); o.y = cvtpk(s4 + 2 <= t ? w.z : 0.f, s4 + 3 <= t ? w.w : 0.f);
        *(LAS u32x2g*)(Ws + t * GT_WS + s4 * 2) = o; }
    __syncthreads();
    { const int ch = tid & 31; const f32x4 g0 = *(const GAS f32x4*)(ln_g + g * 256 + ch * 8), g1 = *(const GAS f32x4*)(ln_g + g * 256 + ch * 8 + 4);
      const f32x4 b0 = *(const GAS f32x4*)(ln_b + g * 256 + ch * 8), b1 = *(const GAS f32x4*)(ln_b + g * 256 + ch * 8 + 4);
      const bool last = (cidx & 15) == 15;
#pragma unroll
      for (int i = 0; i < 8; ++i) { const int row = (tid >> 5) + 16 * i; const v4u x = *(const GAS v4u*)(V + (size_t)(t0 + row) * D + g * 256 + ch * 8); const f32x2g mr = MR[row];
          f32x4 a, b; a.x = (bflo(x.x) - mr.x) * mr.y * g0.x + b0.x; a.y = (bfhi(x.x) - mr.x) * mr.y * g0.y + b0.y; a.z = (bflo(x.y) - mr.x) * mr.y * g0.z + b0.z; a.w = (bfhi(x.y) - mr.x) * mr.y * g0.w + b0.w;
          b.x = (bflo(x.z) - mr.x) * mr.y * g1.x + b1.x; b.y = (bfhi(x.z) - mr.x) * mr.y * g1.y + b1.y; b.z = (bflo(x.w) - mr.x) * mr.y * g1.z + b1.z; b.w = (bfhi(x.w) - mr.x) * mr.y * g1.w + b1.w;
          if (last) { float* o = gvp + ((size_t)((cidx >> 4) * 128 + row)) * D + g * 256 + ch * 8; *(GAS f32x4*)o = a; *(GAS f32x4*)(o + 4) = b; }
          v4u w; w.x = cvtpk(a.x, a.y); w.y = cvtpk(a.z, a.w); w.z = cvtpk(b.x, b.y); w.w = cvtpk(b.z, b.w);
          *(LAS v4u*)(Vs + row * GT_VS + ch * 16) = w; } }
    __syncthreads();
    f32x4 acc[8][2];
    { bf16x8 vf[2][4];
#pragma unroll
      for (int ct = 0; ct < 2; ++ct)
#pragma unroll
          for (int ks = 0; ks < 4; ++ks) { LAS const unsigned char* p = Vs + (32 * ks + 8 * fq + (fr >> 2)) * GT_VS + (32 * wave + 16 * ct + 4 * (fr & 3)) * 2;
              vf[ct][ks] = cat8(ldtr(p), ldtr(p + 4 * GT_VS)); }
#pragma unroll
      for (int tt = 0; tt < 8; ++tt) { acc[tt][0] = (f32x4){0.f, 0.f, 0.f, 0.f}; acc[tt][1] = (f32x4){0.f, 0.f, 0.f, 0.f};
#pragma unroll
          for (int ks = 0; ks < 4; ++ks) if (ks <= (tt >> 1)) { const bf16x8 wf = *(LAS const bf16x8*)(Ws + (16 * tt + fr) * GT_WS + (32 * ks + 8 * fq) * 2);
              acc[tt][0] = __builtin_amdgcn_mfma_f32_16x16x32_bf16(vf[0][ks], wf, acc[tt][0], 0, 0, 0); acc[tt][1] = __builtin_amdgcn_mfma_f32_16x16x32_bf16(vf[1][ks], wf, acc[tt][1], 0, 0, 0); } } }
    __syncthreads();
#pragma unroll
    for (int tt = 0; tt < 8; ++tt) { const int t = 16 * tt + fr; const float bb = b_s[g * 128 + t];
#pragma unroll
        for (int ct = 0; ct < 2; ++ct) { u32x2g o; o.x = cvtpk(acc[tt][ct][0] + bb, acc[tt][ct][1] + bb); o.y = cvtpk(acc[tt][ct][2] + bb, acc[tt][ct][3] + bb);
            *(LAS u32x2g*)(Vs + t * GT_VS + (32 * wave + 16 * ct + 4 * fq) * 2) = o; } }
    __syncthreads();
    { const int ch = tid & 31;
#pragma unroll
      for (int i = 0; i < 8; ++i) { const int row = (tid >> 5) + 16 * i; const v4u s = *(LAS const v4u*)(Vs + row * GT_VS + ch * 16); const size_t go = (size_t)(t0 + row) * D + g * 256 + ch * 8; const v4u x = *(const GAS v4u*)(U + go);
          v4u w; w.x = cvtpk(bflo(x.x) * bflo(s.x), bfhi(x.x) * bfhi(s.x)); w.y = cvtpk(bflo(x.y) * bflo(s.y), bfhi(x.y) * bfhi(s.y));
          w.z = cvtpk(bflo(x.z) * bflo(s.z), bfhi(x.z) * bfhi(s.z)); w.w = cvtpk(bflo(x.w) * bflo(s.w), bfhi(x.w) * bfhi(s.w));
          *(GAS v4u*)(GATED + go) = w; } }
    __syncthreads();
}

constexpr int AT_KS = 144;
constexpr int AT_OFF_K = 0, AT_OFF_V = 256 * AT_KS;
static_assert(AT_OFF_V + 256 * AT_KS <= RING_BYTES, "attention LDS");
__device__ __forceinline__ void attn_unit(LAS unsigned char* lds, int b, int kvh, int qb, const bf16* QKV, bf16* O, const float* sinks, int tid, int wave, int lane) {
    const int fr = lane & 15, fq = lane >> 4;
    LAS unsigned char* Ks = lds + AT_OFF_K; LAS unsigned char* Vs = lds + AT_OFF_V;
    const size_t tokbase = (size_t)b * SEQ + (size_t)128 * qb;
#pragma unroll
    for (int i = 0; i < 4; ++i) { const int idx = tid + 512 * i, row = idx >> 3, ch = idx & 7; v4u kx = (v4u){0u, 0u, 0u, 0u}, vx = (v4u){0u, 0u, 0u, 0u};
        if (qb > 0 || row >= 128) { const bf16* src = QKV + (tokbase - 128 + row) * NQKV + 4096 + kvh * 64 + ch * 8; kx = *(const GAS v4u*)src; vx = *(const GAS v4u*)(src + 512); }
        *(LAS v4u*)(Ks + row * AT_KS + ch * 16) = kx; *(LAS v4u*)(Vs + row * AT_KS + ch * 16) = vx; }
    __syncthreads();
    const int h = kvh * 8 + wave; const float sink = sinks[h];
    for (int qt = 0; qt < 8; ++qt) {
        const bf16* qp = QKV + (tokbase + 16 * qt + fr) * NQKV + h * 64 + 8 * fq;
        const bf16x8 q0 = *(const GAS bf16x8*)qp, q1 = *(const GAS bf16x8*)(qp + 32);
        f32x4 s[16];
#pragma unroll
        for (int jt = 0; jt < 16; ++jt) { LAS const unsigned char* kp = Ks + (16 * jt + fr) * AT_KS + fq * 16;
            f32x4 a = (f32x4){0.f, 0.f, 0.f, 0.f};
            a = __builtin_amdgcn_mfma_f32_16x16x32_bf16(*(LAS const bf16x8*)kp, q0, a, 0, 0, 0);
            a = __builtin_amdgcn_mfma_f32_16x16x32_bf16(*(LAS const bf16x8*)(kp + 64), q1, a, 0, 0, 0); s[jt] = a; }
        const int qi = 16 * qt + fr; float mx = sink;
#pragma unroll
        for (int jt = 0; jt < 16; ++jt)
#pragma unroll
            for (int i = 0; i < 4; ++i) { const int kj = 16 * jt + 4 * fq + i; const bool ok = (kj >= qi) && (kj <= qi + 128) && (qb > 0 || kj >= 128);
                const float v = ok ? s[jt][i] * ATTN_SCALE : -INFINITY; s[jt][i] = v; mx = fmaxf(mx, v); }
        mx = fmaxf(mx, __shfl_xor(mx, 16)); mx = fmaxf(mx, __shfl_xor(mx, 32));
        float l = 0.f;
#pragma unroll
        for (int jt = 0; jt < 16; ++jt)
#pragma unroll
            for (int i = 0; i < 4; ++i) { const float p = __expf(s[jt][i] - mx); s[jt][i] = p; l += p; }
        l += __shfl_xor(l, 16); l += __shfl_xor(l, 32); l += __expf(sink - mx);
        const float inv = 1.0f / l;
        f32x4 o[4];
#pragma unroll
        for (int dt = 0; dt < 4; ++dt) o[dt] = (f32x4){0.f, 0.f, 0.f, 0.f};
#pragma unroll
        for (int ks = 0; ks < 8; ++ks) { v4u pw; pw.x = cvtpk(s[2 * ks][0], s[2 * ks][1]); pw.y = cvtpk(s[2 * ks][2], s[2 * ks][3]); pw.z = cvtpk(s[2 * ks + 1][0], s[2 * ks + 1][1]); pw.w = cvtpk(s[2 * ks + 1][2], s[2 * ks + 1][3]);
            const bf16x8 pb = __builtin_bit_cast(bf16x8, pw);
#pragma unroll
            for (int dt = 0; dt < 4; ++dt) { LAS const unsigned char* vp = Vs + (32 * ks + 4 * fq + (fr >> 2)) * AT_KS + (16 * dt + 4 * (fr & 3)) * 2;
                o[dt] = __builtin_amdgcn_mfma_f32_16x16x32_bf16(cat8(ldtr(vp), ldtr(vp + 16 * AT_KS)), pb, o[dt], 0, 0, 0); } }
        bf16* op = O + (tokbase + 16 * qt + fr) * D + h * 64 + 4 * fq;
#pragma unroll
        for (int dt = 0; dt < 4; ++dt) { u32x2g w; w.x = cvtpk(o[dt][0] * inv, o[dt][1] * inv); w.y = cvtpk(o[dt][2] * inv, o[dt][3] * inv); *(GAS u32x2g*)(op + 16 * dt) = w; }
    }
    __syncthreads();
}

__device__ __forceinline__ void attn_sample_task(int b, int h, const float* qkvs, const float* ck, const float* cv, const float* sinks, bf16* os, int lane) {
    const int kvh = h >> 3;
    const float q = qkvs[(size_t)b * NQKV + h * 64 + lane] * ATTN_SCALE;
    float m = sinks[h], l = 1.0f, o = 0.f;
    const float* kp = ck + ((size_t)b * 128 * 8 + kvh) * 64 + lane; const float* vp = cv + ((size_t)b * 128 * 8 + kvh) * 64 + lane;
#pragma unroll 4
    for (int j = 0; j < 128; ++j) { const float kk = kp[(size_t)j * 512], vv = vp[(size_t)j * 512]; const float s = wave_sum(q * kk);
        const float mn = fmaxf(m, s), al = __expf(m - mn), p = __expf(s - mn); l = l * al + p; o = o * al + p * vv; m = mn; }
    { const float kk = qkvs[(size_t)b * NQKV + 4096 + kvh * 64 + lane], vv = qkvs[(size_t)b * NQKV + 4608 + kvh * 64 + lane]; const float s = wave_sum(q * kk);
      const float mn = fmaxf(m, s), al = __expf(m - mn), p = __expf(s - mn); l = l * al + p; o = o * al + p * vv; m = mn; }
    os[(size_t)b * D + h * 64 + lane] = (bf16)f2bf(o / l);
}

__device__ __forceinline__ void conv_item(int item, const bf16* H, const float* cw, const float* cb, bf16* ACT, int lane) {
    const int tb = item / 22, cc = item % 22, j0 = cc * 512 + lane * 8;
    if (j0 >= DFF) return;
    float wg[3][8], wv[3][8], bg[8], bv[8];
#pragma unroll
    for (int t = 0; t < 3; ++t) { const f32x4 a = *(const GAS f32x4*)(cw + (size_t)t * DFF2 + j0), b = *(const GAS f32x4*)(cw + (size_t)t * DFF2 + j0 + 4), c = *(const GAS f32x4*)(cw + (size_t)t * DFF2 + DFF + j0), d = *(const GAS f32x4*)(cw + (size_t)t * DFF2 + DFF + j0 + 4);
#pragma unroll
        for (int e = 0; e < 4; ++e) { wg[t][e] = a[e]; wg[t][4 + e] = b[e]; wv[t][e] = c[e]; wv[t][4 + e] = d[e]; } }
    { const f32x4 a = *(const GAS f32x4*)(cb + j0), b = *(const GAS f32x4*)(cb + j0 + 4), c = *(const GAS f32x4*)(cb + DFF + j0), d = *(const GAS f32x4*)(cb + DFF + j0 + 4);
#pragma unroll
      for (int e = 0; e < 4; ++e) { bg[e] = a[e]; bg[4 + e] = b[e]; bv[e] = c[e]; bv[4 + e] = d[e]; } }
    float g2[8], g1[8], v2[8], v1[8];
    const int tstart = tb * 32;
    auto unpack = [](const v4u x, float* o) { o[0] = bflo(x.x); o[1] = bfhi(x.x); o[2] = bflo(x.y); o[3] = bfhi(x.y); o[4] = bflo(x.z); o[5] = bfhi(x.z); o[6] = bflo(x.w); o[7] = bfhi(x.w); };
    if ((tstart & (SEQ - 1)) == 0) {
#pragma unroll
        for (int e = 0; e < 8; ++e) { g2[e] = 0.f; g1[e] = 0.f; v2[e] = 0.f; v1[e] = 0.f; }
    } else {
        const bf16* p = H + (size_t)(tstart - 2) * DFF2 + j0;
        unpack(*(const GAS v4u*)p, g2); unpack(*(const GAS v4u*)(p + DFF), v2); unpack(*(const GAS v4u*)(p + DFF2), g1); unpack(*(const GAS v4u*)(p + DFF2 + DFF), v1);
    }
#pragma unroll 2
    for (int t = 0; t < 32; ++t) {
        const bf16* p = H + (size_t)(tstart + t) * DFF2 + j0; float g0[8], v0[8], r[8];
        unpack(*(const GAS v4u*)p, g0); unpack(*(const GAS v4u*)(p + DFF), v0);
#pragma unroll
        for (int e = 0; e < 8; ++e) { const float cg = bg[e] + wg[0][e] * g2[e] + wg[1][e] * g1[e] + wg[2][e] * g0[e]; const float cv = bv[e] + wv[0][e] * v2[e] + wv[1][e] * v1[e] + wv[2][e] * v0[e];
            r[e] = silu_mul(cg, cv); g2[e] = g1[e]; g1[e] = g0[e]; v2[e] = v1[e]; v1[e] = v0[e]; }
        v4u w; w.x = cvtpk(r[0], r[1]); w.y = cvtpk(r[2], r[3]); w.z = cvtpk(r[4], r[5]); w.w = cvtpk(r[6], r[7]);
        *(GAS v4u*)(ACT + (size_t)(tstart + t) * DFF + j0) = w;
    }
}

struct Args { const float* in[N_IN]; float* out; unsigned char* ws; };
static_assert(sizeof(Args) == (N_IN + 2) * 8, "Args has no padding");

#ifndef PHMASK
#define PHMASK 0xFFFFFFFFu
#endif
#define PH(k) if constexpr (((PHMASK) >> (k)) & 1u)
#define CAS __attribute__((address_space(4)))
#define DEFPTRS() const CAS Args* A_ = kargs; asm volatile("" : "+s"(A_)); int tid_ = tid0; asm volatile("" : "+v"(tid_)); const int tid = tid_, lane = tid & 63, wave = __builtin_amdgcn_readfirstlane(tid >> 6), gw = vcu * NWAVES + wave, gt = vcu * NWAVES * 64 + tid; (void)gw; (void)gt; (void)lane; unsigned char* ws = A_->ws; float* out = A_->out; gu32* ctl = (gu32*)(ws + WS_CTL); const float* xp = A_->in[I_XP]; const float* xs = A_->in[I_XS]; const float* cache_k = A_->in[I_CK]; const float* cache_v = A_->in[I_CV]; const float* state_conv = A_->in[I_SC]; const float* nm_pre = A_->in[I_NMPRE]; const float* nm_post = A_->in[I_NMPOST]; const float* nf_pre = A_->in[I_NFPRE]; const float* nf_post = A_->in[I_NFPOST]; bf16* WIN = (bf16*)(ws + WS_WIN); bf16* WOUT = (bf16*)(ws + WS_WOUT); bf16* WQKV = (bf16*)(ws + WS_WQKV); bf16* WO = (bf16*)(ws + WS_WO); bf16* WUP = (bf16*)(ws + WS_WUP); bf16* WDN = (bf16*)(ws + WS_WDN); bf16* HN = (bf16*)(ws + WS_HN); bf16* U = (bf16*)(ws + WS_U); bf16* V = (bf16*)(ws + WS_V); float* VSTAT = (float*)(ws + WS_VSTAT); bf16* GATED = (bf16*)(ws + WS_GATED); float* Y = (float*)(ws + WS_Y); float* X = (float*)(ws + WS_X); bf16* H = (bf16*)(ws + WS_H); bf16* ACT = (bf16*)(ws + WS_ACT); bf16* QKV = (bf16*)(ws + WS_QKV); unsigned char* sm = ws + WS_SMP; bf16* HS = (bf16*)(sm + SM_HS); float* ZS = (float*)(sm + SM_ZS); bf16* GS = (bf16*)(sm + SM_GS); float* YS = (float*)(sm + SM_YS); float* XS = (float*)(sm + SM_XS); float* HHS = (float*)(sm + SM_HHS); bf16* ACTS = (bf16*)(sm + SM_ACTS); float* QKVS = (float*)(sm + SM_QKVS);
__global__ void __launch_bounds__(NWAVES * 64, 2) fwd(Args args) {
    extern __shared__ __attribute__((aligned(16))) unsigned char lds_raw[];
    LAS unsigned char* lds = (LAS unsigned char*)lds_raw;
    volatile LAS unsigned* MISC = (volatile LAS unsigned*)(lds + MISC_OFF);
    const int tid0 = threadIdx.x;
    const int G = gridDim.x, bx = blockIdx.x;
    const int vcu = (G % 8 == 0) ? (bx % 8) * (G / 8) + bx / 8 : bx;
    const int NGW = G * NWAVES, NGT = G * NWAVES * 64;
    const CAS Args* kargs = (const CAS Args*)__builtin_amdgcn_kernarg_segment_ptr();
    for (int u = tid0; u < (LDS_BYTES - LDSCTL_OFF) / 4; u += NWAVES * 64) ((LAS unsigned*)(lds + LDSCTL_OFF))[u] = 0u;
    __syncthreads();
    XcdBarrier bar = xcd_barrier_post((unsigned*)(kargs->ws + WS_CTL) + CW_BAR, MISC + 8);
#define GRID_BAR() xcd_barrier(bar)
#define PROMPT_GEMM(EpiT, Eobj, Aptr, Bptr, Nn, Kk) do { pg8::Gemm g_{(const pg8::bf16_t*)(Aptr), (const pg8::bf16_t*)(Bptr), MP, (Nn), (Kk)}; pg8::StaticOrder S_; S_.init(MP, (Nn), G, bx); \
        pg8::gemm_phase<EpiT, pg8::StaticOrder, true, true>(lds + RING_OFF, g_, S_, Eobj); } while (0)

    PH(0) { DEFPTRS();
        LAS float* scr = (LAS float*)(lds + RING_OFF + wave * 16384);
        constexpr int I_A = 64 * 256, I_B = 64 * 128, I_C = 64 * 160, I_U = 64 * 688, I_D = 172 * 128;
        constexpr int NITEMS = I_A + 2 * I_B + I_C + 2 * I_U + 2 * I_D;
        for (int it = gw; it < NITEMS; it += NGW) {
            int r = it;
            if (r < I_A) { p0_transpose_item(A_->in[I_WIN], D, DZ, WIN, scr, r, lane); continue; } r -= I_A;
            if (r < I_B) { p0_transpose_item(A_->in[I_WOUT], D, D, WOUT, scr, r, lane); continue; } r -= I_B;
            if (r < I_C) { p0_transpose_item(A_->in[I_WQKV], D, NQKV, WQKV, scr, r, lane); continue; } r -= I_C;
            if (r < I_B) { p0_transpose_item(A_->in[I_WO], D, D, WO, scr, r, lane); continue; } r -= I_B;
            if (r < I_U) { p0_transpose_item(A_->in[I_WUP], D, DFF2, WUP, scr, r, lane); continue; } r -= I_U;
            if (r < I_U) { p0_transpose_item(A_->in[I_WUP] + (size_t)D * DFF2, D, DFF2, WUP + (size_t)D * DFF2, scr, r, lane); continue; } r -= I_U;
            if (r < I_D) { p0_transpose_item(A_->in[I_WDN], DFF, D, WDN, scr, r, lane); continue; } r -= I_D;
            p0_transpose_item(A_->in[I_WDN] + (size_t)DFF * D, DFF, D, WDN + (size_t)DFF * D, scr, r, lane);
        }
        for (int r = gw; r < MP + MS; r += NGW) {
            if (r < MP) norm_row_bf16(xp + (size_t)r * D, nm_pre, HN + (size_t)r * D, lane);
            else norm_row_bf16(xs + (size_t)(r - MP) * D, nm_pre, HS + (size_t)(r - MP) * D, lane);
        }
    }
    GRID_BAR();

    PH(1) { DEFPTRS(); pg8::EpiGeluUV E{U, V, VSTAT}; PROMPT_GEMM(pg8::EpiGeluUV, E, HN, WIN, DZ, D);
      skinny_gemm<32, 1>(lds, HS, WIN, DZ, D, ZS, DZ, nullptr, bx, G, tid, wave, lane); }
    GRID_BAR();

    PH(2) { DEFPTRS();
        const float* ln_g = A_->in[I_LNG]; const float* ln_b = A_->in[I_LNB]; const float* w_s = A_->in[I_WS]; const float* b_s = A_->in[I_BS];
        for (int u = bx; u < 64 * 16; u += G) gate_unit(lds, u >> 4, u & 15, U, V, VSTAT, ln_g, ln_b, w_s, b_s, GATED, out + O_GVP, tid, wave, lane);
        if (gw < MS) {
            const int b = gw; const GAS f32x4* vr = (const GAS f32x4*)(ZS + (size_t)b * DZ + D) + lane; const GAS f32x4* ur = (const GAS f32x4*)(ZS + (size_t)b * DZ) + lane;
            f32x4 v[16]; float s = 0.f;
#pragma unroll
            for (int j = 0; j < 16; ++j) { v[j] = vr[64 * j]; s += (v[j].x + v[j].y) + (v[j].z + v[j].w); }
            const float mean = wave_sum(s) * (1.0f / D); float q = 0.f;
#pragma unroll
            for (int j = 0; j < 16; ++j) { v[j] = v[j] - mean; q += (v[j].x * v[j].x + v[j].y * v[j].y) + (v[j].z * v[j].z + v[j].w * v[j].w); }
            const float rstd = 1.0f / sqrtf(wave_sum(q) * (1.0f / D) + NORM_EPS);
            GAS f32x4* go = (GAS f32x4*)(out + O_GVS + (size_t)b * D) + lane; GAS u32x2g* gs = (GAS u32x2g*)(GS + (size_t)b * D) + lane;
#pragma unroll
            for (int j = 0; j < 16; ++j) { const f32x4 gg = ((const GAS f32x4*)ln_g)[lane + 64 * j], bb = ((const GAS f32x4*)ln_b)[lane + 64 * j]; const f32x4 vn = v[j] * rstd * gg + bb; go[64 * j] = vn;
                const float w00 = w_s[(size_t)j * 128 * 128], b0 = b_s[j * 128]; const f32x4 uu = ur[64 * j]; const f32x4 gt4 = uu * (vn * w00 + b0);
                u32x2g w; w.x = cvtpk(gt4.x, gt4.y); w.y = cvtpk(gt4.z, gt4.w); gs[64 * j] = w; }
        }
    }
    GRID_BAR();

    PH(3) { DEFPTRS(); pg8::EpiF32 E{Y, D, nullptr}; PROMPT_GEMM(pg8::EpiF32, E, GATED, WOUT, D, D);
      skinny_gemm<16, 0>(lds, GS, WOUT, D, D, YS, D, nullptr, bx, G, tid, wave, lane); }
    GRID_BAR();

    PH(4) { DEFPTRS(); for (int r = gw; r < MP + MS; r += NGW) {
        if (r < MP) resid_norm_row(Y + (size_t)r * D, xp + (size_t)r * D, nm_post, X + (size_t)r * D, nf_pre, HN + (size_t)r * D, lane);
        else { const size_t o = (size_t)(r - MP) * D; resid_norm_row(YS + o, xs + o, nm_post, XS + o, nf_pre, HS + o, lane); }
    } }
    GRID_BAR();

#define FFN_PHASES(L) \
    PH(5 + 8 * (L)) { DEFPTRS(); pg8::EpiUp E{H, out + O_CVP + (size_t)(L) * NBATCH * 2 * DFF2}; PROMPT_GEMM(pg8::EpiUp, E, HN, WUP + (size_t)(L) * D * DFF2, DFF2, D); \
      skinny_gemm<32, 0>(lds, HS, WUP + (size_t)(L) * D * DFF2, DFF2, D, HHS, DFF2, nullptr, bx, G, tid, wave, lane); } \
    GRID_BAR(); \
    PH(6 + 8 * (L)) { DEFPTRS(); const float* cw = A_->in[I_CW] + (size_t)(L) * 3 * DFF2; const float* cb = A_->in[I_CB] + (size_t)(L) * DFF2; \
      for (int it = gw; it < 256 * 22; it += NGW) conv_item(it, H, cw, cb, ACT, lane); \
      const float* sc = state_conv + (size_t)(L) * MS * 2 * DFF2; float* cvs = out + O_CVS + (size_t)(L) * MS * 2 * DFF2; \
      for (int idx = gt; idx < MS * DFF; idx += NGT) { const int b = idx / DFF, j = idx - b * DFF; \
          const float hg = HHS[(size_t)b * DFF2 + j], hv = HHS[(size_t)b * DFF2 + DFF + j]; \
          const float s0g = sc[((size_t)b * 2 + 0) * DFF2 + j], s1g = sc[((size_t)b * 2 + 1) * DFF2 + j], s0v = sc[((size_t)b * 2 + 0) * DFF2 + DFF + j], s1v = sc[((size_t)b * 2 + 1) * DFF2 + DFF + j]; \
          const float cg = cb[j] + cw[j] * s0g + cw[DFF2 + j] * s1g + cw[2 * DFF2 + j] * hg; \
          const float cv = cb[DFF + j] + cw[DFF + j] * s0v + cw[DFF2 + DFF + j] * s1v + cw[2 * DFF2 + DFF + j] * hv; \
          ACTS[(size_t)b * DFF + j] = (bf16)f2bf(silu_mul(cg, cv)); \
          cvs[((size_t)b * 2 + 0) * DFF2 + j] = s1g; cvs[((size_t)b * 2 + 0) * DFF2 + DFF + j] = s1v; cvs[((size_t)b * 2 + 1) * DFF2 + j] = hg; cvs[((size_t)b * 2 + 1) * DFF2 + DFF + j] = hv; } } \
    GRID_BAR(); \
    PH(7 + 8 * (L)) { DEFPTRS(); pg8::EpiF32 E{Y, D, nullptr}; PROMPT_GEMM(pg8::EpiF32, E, ACT, WDN + (size_t)(L) * DFF * D, D, DFF); \
      skinny_gemm<16, 0>(lds, ACTS, WDN + (size_t)(L) * DFF * D, D, DFF, YS, D, nullptr, bx, G, tid, wave, lane); } \
    GRID_BAR();

    FFN_PHASES(0)

    PH(8) { DEFPTRS(); for (int r = gw; r < MP + MS; r += NGW) {
        if (r < MP) { const size_t o = (size_t)r * D; resid_norm_row(Y + o, X + o, nf_post, X + o, nm_pre + D, HN + o, lane); }
        else { const size_t o = (size_t)(r - MP) * D; resid_norm_row(YS + o, XS + o, nf_post, XS + o, nm_pre + D, HS + o, lane); }
    } }
    GRID_BAR();

    PH(9) { DEFPTRS(); pg8::EpiQkv E{QKV, A_->in[I_BQKV], out + O_WKP, out + O_WVP}; PROMPT_GEMM(pg8::EpiQkv, E, HN, WQKV, NQKV, D);
      skinny_gemm<32, 0>(lds, HS, WQKV, NQKV, D, QKVS, NQKV, A_->in[I_BQKV], bx, G, tid, wave, lane); }
    GRID_BAR();

    PH(10) { DEFPTRS();
        const float* sinks = A_->in[I_SINK];
        for (int u = bx; u < NBATCH * 8 * 16; u += G) attn_unit(lds, u >> 7, (u >> 4) & 7, u & 15, QKV, GATED, sinks, tid, wave, lane);
        for (int t = gw; t < MS * 64; t += NGW) attn_sample_task(t >> 6, t & 63, QKVS, cache_k, cache_v, sinks, GS, lane);
        for (int idx = gt; idx < MS * 128 * 128; idx += NGT) { const int b = idx >> 14, r = (idx >> 7) & 127, c4 = (idx & 127) * 4;
            f32x4 kk, vv;
            if (r < 127) { kk = *(const GAS f32x4*)(cache_k + ((size_t)b * 128 + r + 1) * 512 + c4); vv = *(const GAS f32x4*)(cache_v + ((size_t)b * 128 + r + 1) * 512 + c4); }
            else { kk = *(const GAS f32x4*)(QKVS + (size_t)b * NQKV + 4096 + c4); vv = *(const GAS f32x4*)(QKVS + (size_t)b * NQKV + 4608 + c4); }
            *(GAS f32x4*)(out + O_WKS + ((size_t)b * 128 + r) * 512 + c4) = kk; *(GAS f32x4*)(out + O_WVS + ((size_t)b * 128 + r) * 512 + c4) = vv; }
    }
    GRID_BAR();

    PH(11) { DEFPTRS(); pg8::EpiF32 E{Y, D, A_->in[I_BO]}; PROMPT_GEMM(pg8::EpiF32, E, GATED, WO, D, D);
      skinny_gemm<16, 0>(lds, GS, WO, D, D, YS, D, A_->in[I_BO], bx, G, tid, wave, lane); }
    GRID_BAR();

    PH(12) { DEFPTRS(); for (int r = gw; r < MP + MS; r += NGW) {
        if (r < MP) { const size_t o = (size_t)r * D; resid_norm_row(Y + o, X + o, nm_post + D, X + o, nf_pre + D, HN + o, lane); }
        else { const size_t o = (size_t)(r - MP) * D; resid_norm_row(YS + o, XS + o, nm_post + D, XS + o, nf_pre + D, HS + o, lane); }
    } }
    GRID_BAR();

    FFN_PHASES(1)

    PH(16) { DEFPTRS(); for (int r = gw; r < MP + MS; r += NGW) {
        if (r < MP) { const size_t o = (size_t)r * D; resid_norm_row(Y + o, X + o, nf_post + D, out + O_Y + o, nullptr, nullptr, lane); }
        else { const size_t o = (size_t)(r - MP) * D; resid_norm_row(YS + o, XS + o, nf_post + D, out + O_YS + o, nullptr, nullptr, lane); }
    } }
#undef FFN_PHASES
#undef PROMPT_GEMM
#undef GRID_BAR
}

extern "C" void kernel_launch(void* const* d_in, const int* in_sizes, int n_in, void* d_out, int out_size, void* d_ws, size_t ws_size, hipStream_t stream) {
    static int grid = 0;
    if (grid == 0) {
        if (n_in != N_IN || out_size != (int)O_END || ws_size < WS_END) { fprintf(stderr, "kernel_launch: unexpected problem (n_in %d, out %d, ws %zu; need %d, %zu, >= %zu); nothing launched\n", n_in, out_size, ws_size, (int)N_IN, (size_t)O_END, (size_t)WS_END); grid = -1; return; }
        int dev = 0, cus = 0, per_cu = 0;
        if (hipGetDevice(&dev) != hipSuccess || hipDeviceGetAttribute(&cus, hipDeviceAttributeMultiprocessorCount, dev) != hipSuccess) { grid = -1; return; }
        if (hipFuncSetAttribute((const void*)fwd, hipFuncAttributeMaxDynamicSharedMemorySize, LDS_BYTES) != hipSuccess) { fprintf(stderr, "kernel_launch: hipFuncSetAttribute failed\n"); grid = -1; return; }
        if (hipOccupancyMaxActiveBlocksPerMultiprocessor(&per_cu, (const void*)fwd, NWAVES * 64, LDS_BYTES) != hipSuccess || per_cu < 1) { fprintf(stderr, "kernel_launch: occupancy query says %d blocks per CU\n", per_cu); (void)hipGetLastError(); grid = -1; return; }
        grid = cus;
    }
    if (grid < 0) return;
    if (hipMemsetAsync((char*)d_ws + WS_CTL, 0, CTL_ZERO_BYTES, stream) != hipSuccess) return;
    Args a{};
    for (int i = 0; i < N_IN; ++i) a.in[i] = (const float*)d_in[i];
    a.out = (float*)d_out; a.ws = (unsigned char*)d_ws;
    hipLaunchKernelGGL(fwd, dim3(grid), dim3(NWAVES * 64), LDS_BYTES, stream, a);
}
```

```cpp
#include <hip/hip_runtime.h>
#include <cstdio>
#include <cstdint>
#ifndef PG8_WGM
#define PG8_WGM 8
#endif
#ifndef EPI_UP_I8
#define EPI_UP_I8 true
#endif
#ifndef EPI_IN_I8
#define EPI_IN_I8 false
#endif
#ifndef EPI_QKV_I8
#define EPI_QKV_I8 false
#endif
namespace pg8 {
#define PG8_LAS __attribute__((address_space(3)))
typedef unsigned short bf16_t;
typedef short bf16x8 __attribute__((ext_vector_type(8)));
typedef float f32x4 __attribute__((ext_vector_type(4)));
typedef unsigned u32x4 __attribute__((ext_vector_type(4)));
constexpr int BM = 256, BK = 64, HALF = 128, HTB = HALF * BK * 2  , STAGE_BYTES = 8 * HTB, NXCD = 8, WGM = PG8_WGM;

__host__ __device__ __forceinline__ int lds_byte(int r, int c) { const int st = (r >> 4) * 2 + (c >> 5), rr = r & 15, cc = c & 31, ob = rr * 64 + cc * 2; return st * 1024 + (ob ^ (((ob >> 9) & 1) << 5)); }
__host__ __device__ __forceinline__ void stage_rc(int b, int& R, int& C) { const int st = b / 1024, sb = b % 1024, swz = sb ^ (((sb >> 9) & 1) << 5); R = (st >> 1) * 16 + swz / 64; C = (st & 1) * 32 + (swz % 64) / 2; }
__host__ __device__ __forceinline__ int perm32(int rho) { const int n = rho >> 4, i = rho & 15; return 8 * (i >> 2) + 4 * n + (i & 3); }

struct Unit { int pm, pn; };
struct Gemm { const bf16_t* A; const bf16_t* Bt; int M, N, K; };

struct StaticOrder {
    int nM, nN, nwg, G, c;
    __host__ __device__ void init(int M, int N, int G_, int c_) { nM = M / BM; nN = N / BM; nwg = nM * nN; G = G_; c = c_; }
    __host__ __device__ bool next(int i, Unit& u) const {
        const long L = (long)i * G + c; if (L >= nwg) return false;
        int wgid = (int)L; { const int q = nwg / NXCD, r = nwg % NXCD, xcd = wgid % NXCD, off = wgid / NXCD; wgid = (xcd < r ? xcd * (q + 1) : r * (q + 1) + (xcd - r) * q) + off; }
        const int nig = WGM * nN, gid = wgid / nig, fm = gid * WGM, gsz = (nM - fm) < WGM ? (nM - fm) : WGM;
        u.pm = fm + ((wgid % nig) % gsz); u.pn = (wgid % nig) / gsz; return true;
    }
    __device__ __forceinline__ void a_ready(const Unit&) const {}
    __device__ __forceinline__ void done(const Unit&) const {}
};

__device__ __forceinline__ unsigned cvt_pk_bf16(float lo, float hi) { unsigned r; asm volatile("v_cvt_pk_bf16_f32 %0, %1, %2" : "=v"(r) : "v"(lo), "v"(hi)); return r; }
typedef float f32x2 __attribute__((ext_vector_type(2)));
__device__ __forceinline__ f32x2 gelu_pk(f32x2 v) {
    const f32x2 av = __builtin_elementwise_abs(v), d = av * 0.2316418882f + 1.0f;
    f32x2 t; t.x = __builtin_amdgcn_rcpf(d.x); t.y = __builtin_amdgcn_rcpf(d.y);
    f32x2 q = t * 0.5307027145f + (-0.7265760135f); q = q * t + 0.7107068705f; q = q * t + (-0.142248368f); q = q * t + 0.127414796f; q = q * t;
    const f32x2 s = (v * v) * (-0.72134752044f);
    f32x2 e; e.x = __builtin_amdgcn_exp2f(s.x); e.y = __builtin_amdgcn_exp2f(s.y);
    return v * 0.5f + av * (0.5f - q * e);
}


struct EpiF32 {
    static constexpr bool PERM = false, AFTER_DRAIN = false, APERM = false, I8 = false;
    float* C; int ldc; const float* bias;
    __device__ __forceinline__ void operator()(const f32x4 (&acc)[2][2][4][2], const Unit& u, int wr, int wc, int fr, int fq) const {
        const int row0 = u.pm * BM + wr * 64 + fr, col0 = u.pn * BM + wc * 32 + 4 * fq;
        f32x4 bv[2][2];
#pragma unroll
        for (int bj = 0; bj < 2; ++bj)
#pragma unroll
            for (int n = 0; n < 2; ++n) bv[bj][n] = bias ? *(const f32x4*)(bias + col0 + bj * HALF + n * 16) : (f32x4){0.f, 0.f, 0.f, 0.f};
#pragma unroll
        for (int ai = 0; ai < 2; ++ai)
#pragma unroll
            for (int m = 0; m < 4; ++m) { float* rowp = C + (size_t)(row0 + ai * HALF + m * 16) * ldc + col0;
#pragma unroll
                for (int bj = 0; bj < 2; ++bj)
#pragma unroll
                    for (int n = 0; n < 2; ++n) *(f32x4*)(rowp + bj * HALF + n * 16) = acc[ai][bj][m][n] + bv[bj][n]; }
    }
};
struct EpiBf16B {
    static constexpr bool PERM = true, AFTER_DRAIN = false, APERM = false, I8 = false;
    bf16_t* O; int ldc; const float* bias;
    __device__ __forceinline__ void operator()(const f32x4 (&acc)[2][2][4][2], const Unit& u, int wr, int wc, int fr, int fq) const {
        const int row0 = u.pm * BM + wr * 64 + fr, col0 = u.pn * BM + wc * 32 + 8 * fq;
        f32x4 bv[2][2];
#pragma unroll
        for (int bj = 0; bj < 2; ++bj)
#pragma unroll
            for (int n = 0; n < 2; ++n) bv[bj][n] = bias ? *(const f32x4*)(bias + col0 + bj * HALF + 4 * n) : (f32x4){0.f, 0.f, 0.f, 0.f};
#pragma unroll
        for (int ai = 0; ai < 2; ++ai)
#pragma unroll
            for (int m = 0; m < 4; ++m) { bf16_t* rowp = O + (size_t)(row0 + ai * HALF + m * 16) * ldc + col0;
#pragma unroll
                for (int bj = 0; bj < 2; ++bj) { const f32x4 v0 = acc[ai][bj][m][0] + bv[bj][0], v1 = acc[ai][bj][m][1] + bv[bj][1];
                    u32x4 w; w.x = cvt_pk_bf16(v0[0], v0[1]); w.y = cvt_pk_bf16(v0[2], v0[3]); w.z = cvt_pk_bf16(v1[0], v1[1]); w.w = cvt_pk_bf16(v1[2], v1[3]);
                    *(u32x4*)(rowp + bj * HALF) = w; } }
    }
};
struct EpiBf16BQ {
    static constexpr bool PERM = true, AFTER_DRAIN = false, APERM = false, I8 = true;
    bf16_t* O; int ldc; const float* sa; const float* sw;
    __device__ __forceinline__ void operator()(const f32x4 (&acc)[2][2][4][2], const Unit& u, int wr, int wc, int fr_in, int fq_in) const {
        int fr = fr_in, fq = fq_in; asm volatile("" : "+v"(fr), "+v"(fq));
        const int row0 = u.pm * BM + wr * 64 + fr, col0 = u.pn * BM + wc * 32 + 8 * fq;
        f32x4 sc[2][2];
#pragma unroll
        for (int bj = 0; bj < 2; ++bj)
#pragma unroll
            for (int n = 0; n < 2; ++n) sc[bj][n] = *(const f32x4*)(sw + col0 + bj * HALF + 4 * n);
#pragma unroll
        for (int ai = 0; ai < 2; ++ai)
#pragma unroll
            for (int m = 0; m < 4; ++m) { const float rr = sa[row0 + ai * HALF + m * 16]; bf16_t* rowp = O + (size_t)(row0 + ai * HALF + m * 16) * ldc + col0;
#pragma unroll
                for (int bj = 0; bj < 2; ++bj) { const f32x4 v0 = acc[ai][bj][m][0] * sc[bj][0] * rr, v1 = acc[ai][bj][m][1] * sc[bj][1] * rr;
                    u32x4 w; w.x = cvt_pk_bf16(v0[0], v0[1]); w.y = cvt_pk_bf16(v0[2], v0[3]); w.z = cvt_pk_bf16(v1[0], v1[1]); w.w = cvt_pk_bf16(v1[2], v1[3]);
                    *(u32x4*)(rowp + bj * HALF) = w; } }
    }
};
struct EpiGeluUV {
    static constexpr bool PERM = true, AFTER_DRAIN = false, APERM = false, I8 = EPI_IN_I8;
    bf16_t* U; bf16_t* V; float* vstat; const float* r2; const float* sw;
    __device__ __forceinline__ void operator()(const f32x4 (&acc0)[2][2][4][2], const Unit& u, int wr, int wc, int fr_in, int fq_in) const {
        int fr = fr_in, fq = fq_in; asm volatile("" : "+v"(fr), "+v"(fq));
        f32x4 (&acc)[2][2][4][2] = const_cast<f32x4 (&)[2][2][4][2]>(acc0);
#pragma unroll
        for (int ai = 0; ai < 2; ++ai)
#pragma unroll
            for (int m = 0; m < 4; ++m) { const float rr = r2[u.pm * BM + ai * HALF + wr * 64 + m * 16 + fr];
#pragma unroll
                for (int bj = 0; bj < 2; ++bj)
#pragma unroll
                    for (int n = 0; n < 2; ++n) acc[ai][bj][m][n] *= rr; }
        if (I8) {
#pragma unroll
            for (int bj = 0; bj < 2; ++bj)
#pragma unroll
                for (int n = 0; n < 2; ++n) { const f32x4 sc = *(const f32x4*)(sw + u.pn * BM + wc * 32 + 8 * fq + bj * HALF + 4 * n);
#pragma unroll
                    for (int ai = 0; ai < 2; ++ai)
#pragma unroll
                        for (int m = 0; m < 4; ++m) acc[ai][bj][m][n] *= sc; } }
        const bool isv = u.pn >= 16;
        const int row0 = u.pm * BM + wr * 64 + fr, col0 = (u.pn & 15) * BM + wc * 32 + 8 * fq;
        bf16_t* base = isv ? V : U;
#pragma unroll
        for (int ai = 0; ai < 2; ++ai)
#pragma unroll
            for (int m = 0; m < 4; ++m) { const int row = row0 + ai * HALF + m * 16; bf16_t* rowp = base + (size_t)row * 4096 + col0; float s = 0.f, q = 0.f;
#pragma unroll
                for (int bj = 0; bj < 2; ++bj) { f32x4 v0 = acc[ai][bj][m][0], v1 = acc[ai][bj][m][1];
                    { f32x2 a = gelu_pk((f32x2){v0[0], v0[1]}), b = gelu_pk((f32x2){v0[2], v0[3]}), c = gelu_pk((f32x2){v1[0], v1[1]}), d = gelu_pk((f32x2){v1[2], v1[3]});
                      v0 = (f32x4){a.x, a.y, b.x, b.y}; v1 = (f32x4){c.x, c.y, d.x, d.y}; }
                    s += ((v0[0] + v0[1]) + (v0[2] + v0[3])) + ((v1[0] + v1[1]) + (v1[2] + v1[3]));
                    q += ((v0[0] * v0[0] + v0[1] * v0[1]) + (v0[2] * v0[2] + v0[3] * v0[3])) + ((v1[0] * v1[0] + v1[1] * v1[1]) + (v1[2] * v1[2] + v1[3] * v1[3]));
                    u32x4 w; w.x = cvt_pk_bf16(v0[0], v0[1]); w.y = cvt_pk_bf16(v0[2], v0[3]); w.z = cvt_pk_bf16(v1[0], v1[1]); w.w = cvt_pk_bf16(v1[2], v1[3]);
                    *(u32x4*)(rowp + bj * HALF) = w; }
                if (isv) { s += __shfl_xor(s, 16); s += __shfl_xor(s, 32); q += __shfl_xor(q, 16); q += __shfl_xor(q, 32);
                    if (fq == 0) *(f32x2*)(vstat + ((size_t)row * 64 + (u.pn - 16) * 4 + wc) * 2) = (f32x2){s, q}; } }
    }
};
__device__ __forceinline__ float dpp_shr1(float old, float x) { return __int_as_float(__builtin_amdgcn_update_dpp(__float_as_int(old), __float_as_int(x), 0x111, 0xf, 0xf, false)); }
struct EpiUpConv {
    static constexpr bool PERM = true, AFTER_DRAIN = false, APERM = true, I8 = EPI_UP_I8;
    bf16_t* ACT; float* haloB; float* haloT; const float* cw; const float* cb; PG8_LAS float* xh; const float* r2; const float* sw;
    __device__ __forceinline__ void operator()(const f32x4 (&acc0)[2][2][4][2], const Unit& u, int wr, int wc, int fr_in, int fq_in) const {
        int fr = fr_in, fq = fq_in; asm volatile("" : "+v"(fr), "+v"(fq));
        f32x4 (&acc)[2][2][4][2] = const_cast<f32x4 (&)[2][2][4][2]>(acc0);
        { const f32x4 ra = *(const f32x4*)(r2 + u.pm * BM + 128 * wr + 8 * fr), rb = *(const f32x4*)(r2 + u.pm * BM + 128 * wr + 8 * fr + 4);
#pragma unroll
          for (int ai = 0; ai < 2; ++ai)
#pragma unroll
              for (int m = 0; m < 4; ++m) { const float rr = ai ? rb[m] : ra[m];
#pragma unroll
                  for (int bj = 0; bj < 2; ++bj)
#pragma unroll
                      for (int n = 0; n < 2; ++n) acc[ai][bj][m][n] *= rr; }
          if (I8) {
#pragma unroll
              for (int bj = 0; bj < 2; ++bj)
#pragma unroll
                  for (int n = 0; n < 2; ++n) { const f32x4 sc = *(const f32x4*)(sw + u.pn * 256 + wc * 32 + 8 * fq + bj * 128 + 4 * n);
#pragma unroll
                      for (int ai = 0; ai < 2; ++ai)
#pragma unroll
                          for (int m = 0; m < 4; ++m) acc[ai][bj][m][n] *= sc; } } }
        const int colh = u.pn * 128 + wc * 32 + 8 * fq;
        const int colt = u.pn * 256 + wc * 32 + 8 * fq;
        if (wr == 1 && fr == 15) {
#pragma unroll
            for (int t = 0; t < 2; ++t) { float* d = haloB + (size_t)(u.pm * 2 + t) * 22016 + colt;
#pragma unroll
                for (int bj = 0; bj < 2; ++bj)
#pragma unroll
                    for (int n = 0; n < 2; ++n) *(f32x4*)(d + bj * 128 + 4 * n) = acc[1][bj][2 + t][n];
            }
        }
        if (wr == 0 && fr == 0) {
#pragma unroll
            for (int t = 0; t < 2; ++t) { float* d = haloT + (size_t)(u.pm * 2 + t) * 22016 + colt;
#pragma unroll
                for (int bj = 0; bj < 2; ++bj)
#pragma unroll
                    for (int n = 0; n < 2; ++n) *(f32x4*)(d + bj * 128 + 4 * n) = acc[0][bj][t][n]; }
        }
        PG8_LAS float* xp = xh + (wc * 4 + fq) * 32;
        if (wr == 0 && fr == 15) {
#pragma unroll
            for (int t = 0; t < 2; ++t)
#pragma unroll
                for (int bj = 0; bj < 2; ++bj)
#pragma unroll
                    for (int n = 0; n < 2; ++n) *(PG8_LAS f32x4*)(xp + t * 16 + bj * 8 + n * 4) = acc[1][bj][2 + t][n];
        }
        asm volatile("s_waitcnt lgkmcnt(0)" ::: "memory"); __builtin_amdgcn_s_barrier(); asm volatile("" ::: "memory");
        unsigned pk0[8][2];
        f32x2 nl = (f32x2){-1.44269504089f, -1.44269504089f}; asm volatile("" : "+v"(nl)); const f32x4 nl2e = (f32x4){nl.x, nl.y, nl.x, nl.y};
#pragma unroll
        for (int n = 0; n < 2; ++n) {
            f32x4 wg[3], wv[3];
#pragma unroll
            for (int t = 0; t < 3; ++t) { wg[t] = *(const f32x4*)(cw + (size_t)t * 22016 + colh + 4 * n); wv[t] = *(const f32x4*)(cw + (size_t)t * 22016 + 11008 + colh + 4 * n); }
            const f32x4 bg = *(const f32x4*)(cb + colh + 4 * n), bv = *(const f32x4*)(cb + 11008 + colh + 4 * n);
            f32x4 og2 = (f32x4){0.f, 0.f, 0.f, 0.f}, og1 = og2, ov2 = og2, ov1 = og2;
            if (wr == 1) { og2 = *(PG8_LAS const f32x4*)(xp + n * 4); og1 = *(PG8_LAS const f32x4*)(xp + 16 + n * 4); ov2 = *(PG8_LAS const f32x4*)(xp + 8 + n * 4); ov1 = *(PG8_LAS const f32x4*)(xp + 24 + n * 4); }
            f32x4 pg2, pg1, pv2, pv1;
#pragma unroll
            for (int i = 0; i < 4; ++i) { pg2[i] = dpp_shr1(og2[i], acc[1][0][2][n][i]); pg1[i] = dpp_shr1(og1[i], acc[1][0][3][n][i]); pv2[i] = dpp_shr1(ov2[i], acc[1][1][2][n][i]); pv1[i] = dpp_shr1(ov1[i], acc[1][1][3][n][i]); }
#pragma unroll
            for (int e = 0; e < 8; ++e) { const f32x4 xg = acc[e >> 2][0][e & 3][n], xv = acc[e >> 2][1][e & 3][n];
                const f32x4 cg = bg + wg[0] * pg2 + wg[1] * pg1 + wg[2] * xg, cv = bv + wv[0] * pv2 + wv[1] * pv1 + wv[2] * xv;
                const f32x4 tt = cg * nl2e; f32x4 ee, rc;
#pragma unroll
                for (int i = 0; i < 4; ++i) ee[i] = __builtin_amdgcn_exp2f(tt[i]);
                ee = ee + 1.0f;
#pragma unroll
                for (int i = 0; i < 4; ++i) rc[i] = __builtin_amdgcn_rcpf(ee[i]);
                const f32x4 r = cg * cv * rc;
                pg2 = pg1; pg1 = xg; pv2 = pv1; pv1 = xv;
                const unsigned lo = cvt_pk_bf16(r[0], r[1]), hi = cvt_pk_bf16(r[2], r[3]);
                if (n == 0) { pk0[e][0] = lo; pk0[e][1] = hi; }
                else { u32x4 w; w.x = pk0[e][0]; w.y = pk0[e][1]; w.z = lo; w.w = hi;
                    *(u32x4*)(ACT + (size_t)(u.pm * BM + wr * 128 + fr * 8 + e) * 11008 + colh) = w; } }
        }
    }
};
struct EpiQkv {
    static constexpr bool PERM = true, AFTER_DRAIN = false, APERM = false, I8 = EPI_QKV_I8;
    bf16_t* QKV; const float* bias; float* wk; float* wv; const float* r2; const float* sw;
    __device__ __forceinline__ void operator()(const f32x4 (&acc0)[2][2][4][2], const Unit& u, int wr, int wc, int fr_in, int fq_in) const {
        int fr = fr_in, fq = fq_in; asm volatile("" : "+v"(fr), "+v"(fq));
        f32x4 (&acc)[2][2][4][2] = const_cast<f32x4 (&)[2][2][4][2]>(acc0);
#pragma unroll
        for (int ai = 0; ai < 2; ++ai)
#pragma unroll
            for (int m = 0; m < 4; ++m) { const float rr = r2[u.pm * BM + ai * HALF + wr * 64 + m * 16 + fr];
#pragma unroll
                for (int bj = 0; bj < 2; ++bj)
#pragma unroll
                    for (int n = 0; n < 2; ++n) acc[ai][bj][m][n] *= rr; }
        if (I8) {
#pragma unroll
            for (int bj = 0; bj < 2; ++bj)
#pragma unroll
                for (int n = 0; n < 2; ++n) { const f32x4 sc = *(const f32x4*)(sw + u.pn * BM + wc * 32 + 8 * fq + bj * HALF + 4 * n);
#pragma unroll
                    for (int ai = 0; ai < 2; ++ai)
#pragma unroll
                        for (int m = 0; m < 4; ++m) acc[ai][bj][m][n] *= sc; } }
        const int row0 = u.pm * BM + wr * 64 + fr, col0 = u.pn * BM + wc * 32 + 8 * fq;
        const bool win = ((u.pm & 7) == 7) && (u.pn >= 16);
        f32x4 bv[2][2];
#pragma unroll
        for (int bj = 0; bj < 2; ++bj)
#pragma unroll
            for (int n = 0; n < 2; ++n) bv[bj][n] = *(const f32x4*)(bias + col0 + bj * HALF + 4 * n);
#pragma unroll
        for (int ai = 0; ai < 2; ++ai)
#pragma unroll
            for (int m = 0; m < 4; ++m) { bf16_t* rowp = QKV + (size_t)(row0 + ai * HALF + m * 16) * 5120 + col0;
#pragma unroll
                for (int bj = 0; bj < 2; ++bj) { const f32x4 v0 = acc[ai][bj][m][0] + bv[bj][0], v1 = acc[ai][bj][m][1] + bv[bj][1];
                    u32x4 w; w.x = cvt_pk_bf16(v0[0], v0[1]); w.y = cvt_pk_bf16(v0[2], v0[3]); w.z = cvt_pk_bf16(v1[0], v1[1]); w.w = cvt_pk_bf16(v1[2], v1[3]);
                    *(u32x4*)(rowp + bj * HALF) = w;
                    if (win && ai == 1) { float* dst = (u.pn >= 18 ? wv : wk) + (size_t)((u.pm >> 3) * 128 + wr * 64 + m * 16 + fr) * 512 + ((u.pn - 16) & 1) * 256 + wc * 32 + 8 * fq + bj * HALF;
                        *(f32x4*)dst = v0; *(f32x4*)(dst + 4) = v1; } } }
    }
};
typedef int i32x4 __attribute__((ext_vector_type(4)));
template <bool I8> __device__ __forceinline__ f32x4 pg8_mma(bf16x8 b, bf16x8 a, f32x4 c) {
    if constexpr (I8) return __builtin_bit_cast(f32x4, __builtin_amdgcn_mfma_i32_16x16x64_i8(__builtin_bit_cast(i32x4, b), __builtin_bit_cast(i32x4, a), __builtin_bit_cast(i32x4, c), 0, 0, 0));
    else return __builtin_amdgcn_mfma_f32_16x16x32_bf16(b, a, c, 0, 0, 0);
}
template <class Epi, class Sched, bool ALIGN_EPI = false, bool SP2 = false>
__device__ __forceinline__ void gemm_phase(PG8_LAS unsigned char* lds, const Gemm g, const Sched& S, const Epi& E) {
    int tid_l = threadIdx.x; asm volatile("" : "+v"(tid_l));
    const int tid = tid_l, wid = __builtin_amdgcn_readfirstlane(tid >> 6), lane = tid & 63, wr = wid >> 2, wc = wid & 3, fr = lane & 15, fq = lane >> 4;
    const int K = g.K, nt = K / BK;
    unsigned voffA[2], voffB[2];
#pragma unroll
    for (int i = 0; i < 2; ++i) { int R, C; stage_rc(tid * 16 + i * 8192, R, C); const int Rb = Epi::PERM ? ((R & ~31) + perm32(R & 31)) : R;
        const int Ra = Epi::APERM ? (128 * (R >> 6) + 8 * (R & 15) + ((R >> 4) & 3)) : R;
        voffA[i] = (unsigned)(Ra * K + C) * 2u; voffB[i] = (unsigned)(Rb * K + C) * 2u; }
    const size_t kstep = (size_t)(BK * 2);
    const size_t hstep = (size_t)HALF * K * 2;
    const size_t hstepA = Epi::APERM ? (size_t)4 * K * 2 : hstep;
    const size_t tstep = 2 * hstep;
    const unsigned ldsw = (unsigned)wid * 1024u;
    const int aoff = lds_byte(wr * 64 + fr, fq * 8), boff = lds_byte(wc * 32 + fr, fq * 8);
#define PG8_SA(b, h) (((b) * 2 + (h)) * HTB)
#define PG8_SB(b, h) ((4 + (b) * 2 + (h)) * HTB)
#define PG8_STAGE(bufoff, gbase, voff) do { _Pragma("unroll") for (int _i = 0; _i < 2; ++_i) \
        __builtin_amdgcn_global_load_lds((const unsigned*)((const char*)(gbase) + (voff)[_i]), (PG8_LAS unsigned*)(lds + (bufoff) + ldsw + _i * 8192), 16, 0, 0); } while (0)
#define PG8_LDA(dst, b, h) do { _Pragma("unroll") for (int m = 0; m < 4; ++m) _Pragma("unroll") for (int k = 0; k < 2; ++k) dst[m][k] = *(const PG8_LAS bf16x8*)(lds + PG8_SA(b, h) + aoff + m * 2048 + k * 1024); } while (0)
#define PG8_LDB(dst, b, h) do { _Pragma("unroll") for (int n = 0; n < 2; ++n) _Pragma("unroll") for (int k = 0; k < 2; ++k) dst[n][k] = *(const PG8_LAS bf16x8*)(lds + PG8_SB(b, h) + boff + n * 2048 + k * 1024); } while (0)
#define PG8_MMA(ai, bj, At, Bt) do { __builtin_amdgcn_s_setprio(1); _Pragma("unroll") for (int m = 0; m < 4; ++m) _Pragma("unroll") for (int n = 0; n < 2; ++n) _Pragma("unroll") for (int k = 0; k < 2; ++k) \
        acc[ai][bj][m][n] = pg8_mma<Epi::I8>(Bt[n][k], At[m][k], acc[ai][bj][m][n]); __builtin_amdgcn_s_setprio(0); } while (0)
#define PG8_WAIT_V(n) asm volatile("s_waitcnt vmcnt(" #n ")" ::: "memory")
#define PG8_WAIT_L(n) asm volatile("s_waitcnt lgkmcnt(" #n ")" ::: "memory")
#define PG8_BAR __builtin_amdgcn_s_barrier()
#define PG8_SCHED __builtin_amdgcn_sched_barrier(0)
    Unit cur, nxt; int ui = 0;
    if (!S.next(0, cur)) return;
    f32x4 acc[2][2][4][2];
#pragma unroll
    for (int a = 0; a < 2; ++a)
#pragma unroll
        for (int b = 0; b < 2; ++b)
#pragma unroll
            for (int m = 0; m < 4; ++m)
#pragma unroll
                for (int n = 0; n < 2; ++n) acc[a][b][m][n] = (f32x4){0.f, 0.f, 0.f, 0.f};
    bf16x8 At[4][2], B0[2][2], B1[2][2];
    const char* cA = (const char*)g.A + (size_t)cur.pm * tstep; const char* cB = (const char*)g.Bt + (size_t)cur.pn * tstep;
    S.a_ready(cur);
    if constexpr (SP2) {
        PG8_STAGE(PG8_SB(0, 0), cB, voffB); PG8_STAGE(PG8_SB(0, 1), cB + hstep, voffB); PG8_STAGE(PG8_SA(0, 0), cA, voffA); PG8_STAGE(PG8_SA(0, 1), cA + hstepA, voffA);
        if (wr == 1) PG8_BAR;
        PG8_WAIT_V(2); PG8_BAR;
        PG8_STAGE(PG8_SB(1, 0), cB + kstep, voffB); PG8_STAGE(PG8_SA(1, 0), cA + kstep, voffA); PG8_STAGE(PG8_SB(1, 1), cB + hstep + kstep, voffB);
        PG8_WAIT_V(6); PG8_BAR;
    } else {
        PG8_STAGE(PG8_SB(0, 0), cB, voffB); PG8_STAGE(PG8_SA(0, 0), cA, voffA); PG8_STAGE(PG8_SB(0, 1), cB + hstep, voffB); PG8_STAGE(PG8_SA(0, 1), cA + hstepA, voffA);
        if (wr == 1) PG8_BAR;
        PG8_WAIT_V(4); PG8_BAR;
        PG8_STAGE(PG8_SB(1, 0), cB + kstep, voffB); PG8_STAGE(PG8_SA(1, 0), cA + kstep, voffA); PG8_STAGE(PG8_SB(1, 1), cB + hstep + kstep, voffB);
        PG8_WAIT_V(6); PG8_BAR;
    }
    for (;;) {
        const bool has_next = S.next(ui + 1, nxt);
        const char* nA = has_next ? (const char*)g.A + (size_t)nxt.pm * tstep : cA; const char* nB = has_next ? (const char*)g.Bt + (size_t)nxt.pn * tstep : cB;
        for (int t = 0; t < nt; t += 2) {
            const bool last = (t == nt - 2);
            const char* a1 = cA + (size_t)(t + 1) * kstep;
            const char* a2 = last ? nA : cA + (size_t)(t + 2) * kstep; const char* b2 = last ? nB : cB + (size_t)(t + 2) * kstep;
            const char* a3 = a2 + kstep; const char* b3 = b2 + kstep;
            if (last && has_next) S.a_ready(nxt);
            if constexpr (SP2) {
            PG8_LDB(B0, 0, 0); PG8_LDB(B1, 0, 1); PG8_SCHED; PG8_LDA(At, 0, 0); PG8_STAGE(PG8_SA(1, 1), a1 + hstepA, voffA);
            PG8_WAIT_V(8); PG8_WAIT_L(0); PG8_BAR; PG8_MMA(0, 0, At, B0); PG8_MMA(0, 1, At, B1); PG8_BAR; PG8_SCHED;
            PG8_LDA(At, 0, 1); PG8_STAGE(PG8_SB(0, 0), b2, voffB); PG8_STAGE(PG8_SB(0, 1), b2 + hstep, voffB); PG8_STAGE(PG8_SA(0, 0), a2, voffA);
            PG8_WAIT_V(8); PG8_WAIT_L(0); PG8_BAR; PG8_MMA(1, 0, At, B0); PG8_MMA(1, 1, At, B1); PG8_BAR; PG8_SCHED;
            PG8_LDB(B0, 1, 0); PG8_LDB(B1, 1, 1); PG8_SCHED; PG8_LDA(At, 1, 0); PG8_STAGE(PG8_SA(0, 1), a2 + hstepA, voffA);
            PG8_WAIT_V(8); PG8_WAIT_L(0); PG8_BAR; PG8_MMA(0, 0, At, B0); PG8_MMA(0, 1, At, B1); PG8_BAR; PG8_SCHED;
            PG8_LDA(At, 1, 1); PG8_STAGE(PG8_SB(1, 0), b3, voffB); PG8_STAGE(PG8_SB(1, 1), b3 + hstep, voffB); PG8_STAGE(PG8_SA(1, 0), a3, voffA);
            PG8_WAIT_V(8); PG8_WAIT_L(0); PG8_BAR; PG8_MMA(1, 0, At, B0); PG8_MMA(1, 1, At, B1); PG8_BAR; PG8_SCHED;
            } else {
            PG8_LDB(B0, 0, 0); PG8_SCHED; PG8_LDA(At, 0, 0); PG8_STAGE(PG8_SA(1, 1), a1 + hstepA, voffA);
            PG8_WAIT_L(8); PG8_BAR; PG8_WAIT_L(0); PG8_MMA(0, 0, At, B0); PG8_BAR; PG8_SCHED;
            PG8_LDB(B1, 0, 1); PG8_STAGE(PG8_SB(0, 0), b2, voffB);
            PG8_BAR; PG8_WAIT_L(0); PG8_MMA(0, 1, At, B1); PG8_BAR;
            PG8_LDA(At, 0, 1); PG8_STAGE(PG8_SA(0, 0), a2, voffA);
            PG8_BAR; PG8_WAIT_L(0); PG8_MMA(1, 0, At, B0); PG8_BAR; PG8_SCHED;
            PG8_STAGE(PG8_SB(0, 1), b2 + hstep, voffB);
            PG8_WAIT_V(6); PG8_BAR; PG8_MMA(1, 1, At, B1); PG8_BAR;
            PG8_LDB(B0, 1, 0); PG8_SCHED; PG8_LDA(At, 1, 0); PG8_STAGE(PG8_SA(0, 1), a2 + hstepA, voffA);
            PG8_WAIT_L(8); PG8_BAR; PG8_WAIT_L(0); PG8_MMA(0, 0, At, B0); PG8_BAR; PG8_SCHED;
            PG8_LDB(B1, 1, 1); PG8_STAGE(PG8_SB(1, 0), b3, voffB);
            PG8_BAR; PG8_WAIT_L(0); PG8_MMA(0, 1, At, B1); PG8_BAR;
            PG8_LDA(At, 1, 1); PG8_STAGE(PG8_SA(1, 0), a3, voffA);
            PG8_BAR; PG8_WAIT_L(0); PG8_MMA(1, 0, At, B0); PG8_BAR; PG8_SCHED;
            PG8_STAGE(PG8_SB(1, 1), b3 + hstep, voffB);
            PG8_WAIT_V(6); PG8_BAR; PG8_MMA(1, 1, At, B1); PG8_BAR;
            }
        }
        if constexpr (ALIGN_EPI) { if (wr == 0) PG8_BAR; }
        if constexpr (Epi::I8) {
#pragma unroll
            for (int a = 0; a < 2; ++a)
#pragma unroll
                for (int b = 0; b < 2; ++b)
#pragma unroll
                    for (int m = 0; m < 4; ++m)
#pragma unroll
                        for (int n = 0; n < 2; ++n) acc[a][b][m][n] = __builtin_convertvector(__builtin_bit_cast(i32x4, acc[a][b][m][n]), f32x4); }
        if constexpr (!Epi::AFTER_DRAIN) { E(acc, cur, wr, wc, fr, fq); S.done(cur); }
        if (!has_next) break;
#pragma unroll
        for (int a = 0; a < 2; ++a)
#pragma unroll
            for (int b = 0; b < 2; ++b)
#pragma unroll
                for (int m = 0; m < 4; ++m)
#pragma unroll
                    for (int n = 0; n < 2; ++n) acc[a][b][m][n] = (f32x4){0.f, 0.f, 0.f, 0.f};
        cur = nxt; cA = nA; cB = nB; ++ui;
        if constexpr (ALIGN_EPI) { if (wr == 1) PG8_BAR; }
    }
    PG8_WAIT_V(0);
    if constexpr (!ALIGN_EPI) { if (wr == 0) PG8_BAR; }
    PG8_BAR;
    if constexpr (Epi::AFTER_DRAIN) { E.fused(acc, cur, wr, wc, fr, fq, lds, wid, lane); S.done(cur); }
#undef PG8_SA
#undef PG8_SB
#undef PG8_STAGE
#undef PG8_LDA
#undef PG8_LDB
#undef PG8_MMA
#undef PG8_WAIT_V
#undef PG8_WAIT_L
#undef PG8_BAR
#undef PG8_SCHED
}
}
#define GAS __attribute__((address_space(1)))
#define LAS __attribute__((address_space(3)))
typedef unsigned short bf16;
typedef unsigned v4u __attribute__((ext_vector_type(4)));
typedef float f32x4 __attribute__((ext_vector_type(4)));
typedef short bf16x8 __attribute__((ext_vector_type(8)));
typedef GAS unsigned gu32;
typedef GAS unsigned long long gu64;
#define RLX_AGENT __ATOMIC_RELAXED, __HIP_MEMORY_SCOPE_AGENT
#define LDS_WAIT() asm volatile("s_waitcnt lgkmcnt(0)" ::: "memory")
#define VM_WAIT() asm volatile("s_waitcnt vmcnt(0)" ::: "memory")
__device__ __forceinline__ unsigned long long rt() { return __builtin_amdgcn_s_memrealtime(); }
__device__ __forceinline__ unsigned f2bf(float f) { unsigned u = __builtin_bit_cast(unsigned, f); return (u + 0x7fffu + ((u >> 16) & 1u)) >> 16; }
__device__ __forceinline__ unsigned pk2(float lo, float hi) { return f2bf(lo) | (f2bf(hi) << 16); }

#define XB_TMO      128
#define XB_XCNT(j)  (256  + 64 * (j))
#define XB_XSUB(j)  (1280 + 64 * (j))
#define XB_XGEN(j)  (2304 + 64 * (j))
#define XB_TOP      3328
#define XB_TOPGEN   3392
#define XCD_BAR_WORDS 3456
#define XB_SPIN_CAP (1u << 18)

__device__ __forceinline__ unsigned xb_ld(unsigned* p)              { return __hip_atomic_load(p, __ATOMIC_RELAXED, __HIP_MEMORY_SCOPE_AGENT); }
__device__ __forceinline__ unsigned xb_add(unsigned* p, unsigned v) { return __hip_atomic_fetch_add(p, v, __ATOMIC_RELAXED, __HIP_MEMORY_SCOPE_AGENT); }
__device__ __forceinline__ unsigned xb_xcc_id() { return (unsigned)__builtin_amdgcn_s_getreg((3 << 11) | 20) & 0xFu; }
#define XB_SPIN(cond, bar) do { unsigned _sp = 0; while (cond) { __builtin_amdgcn_s_sleep(1); \
    if ((++_sp & 255u) == 0u) { if (xb_ld(&(bar)[XB_TMO])) break; if (_sp > XB_SPIN_CAP) { atomicAdd(&(bar)[XB_TMO], 1u); break; } } } } while (0)

struct XcdBarrier {
    unsigned* bar; unsigned x;
    volatile LAS unsigned* st;
};

__device__ __forceinline__ XcdBarrier xcd_barrier_post(unsigned* bar, volatile LAS unsigned* st) {
    XcdBarrier b; b.bar = bar; b.x = xb_xcc_id(); b.st = st;
    if (threadIdx.x == 0) (void)xb_add(&bar[XB_XCNT(b.x)], 1u);
    return b;
}
__device__ __forceinline__ void xcd_barrier_complete(unsigned* bar, unsigned x, unsigned& nloc, unsigned& nx) {
    const unsigned G = gridDim.x * gridDim.y * gridDim.z;
    unsigned sum, cnt, mine, sp = 0u;
    for (;;) {
        sum = 0u; cnt = 0u; mine = 0u;
#pragma unroll
        for (unsigned j = 0; j < 16; ++j) { const unsigned c = xb_ld(&bar[XB_XCNT(j)]); sum += c; cnt += (c > 0u) ? 1u : 0u; mine = (j == x) ? c : mine; }
        if (sum == G) break;
        __builtin_amdgcn_s_sleep(1);
        if ((++sp & 255u) == 0u) { if (xb_ld(&bar[XB_TMO])) break; if (sp > XB_SPIN_CAP) { atomicAdd(&bar[XB_TMO], 1u); break; } }
    }
    nloc = mine > 0u ? mine : 1u; nx = cnt > 0u ? cnt : 1u;
}

__device__ __forceinline__ void xcd_barrier(const XcdBarrier& b) {
    asm volatile("s_waitcnt vmcnt(0)" ::: "memory");
    __syncthreads();
    if (threadIdx.x == 0) {
        unsigned* bar = b.bar;
        __builtin_amdgcn_s_waitcnt(0);
        unsigned nloc = b.st[0], nx = b.st[1];
        if (nloc == 0u) { xcd_barrier_complete(bar, b.x, nloc, nx); b.st[0] = nloc; b.st[1] = nx; }
        const unsigned old = xb_add(&bar[XB_XSUB(b.x)], 1u);
        const unsigned gen = old / nloc;
        if (old + 1u == (gen + 1u) * nloc) {
            __builtin_amdgcn_fence(__ATOMIC_RELEASE, "agent");
            asm volatile("s_waitcnt vmcnt(0)" ::: "memory");
            const unsigned og = xb_add(&bar[XB_TOP], 1u);
            const unsigned tg = og / nx;
            if (og + 1u == (tg + 1u) * nx) xb_add(&bar[XB_TOPGEN], 1u);
            else XB_SPIN(xb_ld(&bar[XB_TOPGEN]) == tg, bar);
            __builtin_amdgcn_fence(__ATOMIC_ACQUIRE, "agent");
            xb_add(&bar[XB_XGEN(b.x)], 1u);
            asm volatile("s_waitcnt vmcnt(0)" ::: "memory");
        } else {
            XB_SPIN(xb_ld(&bar[XB_XGEN(b.x)]) == gen, bar);
            __builtin_amdgcn_fence(__ATOMIC_ACQUIRE, "agent");
            asm volatile("s_waitcnt vmcnt(0)" ::: "memory");
        }
    }
    __syncthreads();
}

constexpr int D = 4096, MP = 8192, MS = 32, SEQ = 2048, NBATCH = 4;
constexpr int DFF = 11008, DFF2 = 22016, NQKV = 5120, DZ = 8192;
constexpr float NORM_EPS = 1e-6f, ATTN_SCALE = 0.125f;
constexpr int NWAVES = 8;

enum { I_XP = 0, I_XS, I_CK, I_CV, I_SC, I_NMPRE, I_NMPOST, I_NFPRE, I_NFPOST, I_WIN, I_LNG, I_LNB, I_WS, I_BS, I_WOUT, I_WQKV, I_BQKV, I_SINK, I_WO, I_BO, I_WUP, I_CW, I_CB, I_WDN, N_IN };
constexpr size_t O_Y = 0, O_YS = O_Y + (size_t)MP * D, O_GVP = O_YS + (size_t)MS * D, O_GVS = O_GVP + (size_t)NBATCH * 128 * D, O_WKP = O_GVS + (size_t)MS * D,
                 O_WVP = O_WKP + (size_t)NBATCH * 128 * 512, O_WKS = O_WVP + (size_t)NBATCH * 128 * 512, O_WVS = O_WKS + (size_t)MS * 128 * 512, O_CVP = O_WVS + (size_t)MS * 128 * 512,
                 O_CVS = O_CVP + (size_t)2 * NBATCH * 2 * DFF2, O_END = O_CVS + (size_t)2 * MS * 2 * DFF2;
static_assert(O_END == 43802624, "output size");

constexpr size_t MiB = 1u << 20;
constexpr size_t WS_CTL = 0, CTL_ZERO_BYTES = 32768;
constexpr size_t WS_WIN = 1 * MiB;
constexpr size_t WS_WOUT = WS_WIN + 64 * MiB;
constexpr size_t WS_WQKV = WS_WOUT + 32 * MiB;
constexpr size_t WS_WO = WS_WQKV + 40 * MiB;
constexpr size_t WS_WUP = WS_WO + 32 * MiB;
constexpr size_t WS_WDN = WS_WUP + 2 * 172 * MiB;
constexpr size_t WS_HN = WS_WDN + 2 * 86 * MiB;
constexpr size_t WS_U = WS_HN + 64 * MiB;
constexpr size_t WS_V = WS_U + 64 * MiB;
constexpr size_t WS_VSTAT = WS_V + 64 * MiB;
constexpr size_t WS_GATED = WS_VSTAT + 4 * MiB;
constexpr size_t WS_Y = WS_GATED + 64 * MiB;
constexpr size_t WS_X = WS_Y + 128 * MiB;
constexpr size_t WS_RQ = WS_X + 65 * MiB;
constexpr size_t WS_SW = WS_X + 66 * MiB;
constexpr size_t WS_XQ = WS_X + 68 * MiB;
constexpr size_t WS_R2 = WS_X + 64 * MiB;
constexpr size_t WS_HALOB = WS_X + 128 * MiB;
constexpr size_t WS_HALOT = WS_HALOB + 6 * MiB;
constexpr size_t WS_ACT = WS_HALOT + 6 * MiB;
constexpr size_t WS_QKV = WS_ACT + 172 * MiB;
constexpr size_t WS_WQUP = WS_QKV + 80 * MiB;
constexpr size_t WS_WQIN = WS_WQUP + 172 * MiB;
constexpr size_t WS_WQQKV = WS_WQIN + 32 * MiB;
constexpr size_t WS_SMP = WS_WQQKV + 20 * MiB;
constexpr size_t SM_HS = 0;
constexpr size_t SM_ZS = SM_HS + 512 * 1024;
constexpr size_t SM_GS = SM_ZS + 1024 * 1024;
constexpr size_t SM_YS = SM_GS + 256 * 1024;
constexpr size_t SM_XS = SM_YS + 512 * 1024;
constexpr size_t SM_HHS = SM_XS + 512 * 1024;
constexpr size_t SM_ACTS = SM_HHS + 3 * 1024 * 1024;
constexpr size_t SM_QKVS = SM_ACTS + 1024 * 1024;
constexpr size_t SM_HSQ = 7680 * 1024;
constexpr size_t SM_SAS = 7936 * 1024 + 1024;
constexpr size_t SM_HSS = 7936 * 1024;
static_assert(SM_QKVS + 32 * 5120 * 4 <= SM_HSQ && SM_HSQ + 48 * 4096 <= SM_HSS && SM_SAS + 256 <= 8 * MiB, "sample buffers");
constexpr size_t WS_WQDN = WS_SMP + 8 * MiB;
constexpr size_t WS_ACTQ = WS_U;
constexpr size_t WS_SA = WS_X + 67 * MiB;
constexpr size_t WS_END = WS_WQDN + 86 * MiB;
static_assert(SM_QKVS + 32 * 5120 * 4 <= 8 * MiB, "sample buffers");
constexpr int CW_CMAX = 8192;
constexpr int NQCOL = 2 * 22016 + 8192 + 5120 + 2 * 4096;
constexpr int QC_DN = 2 * 22016 + 8192 + 5120;
constexpr size_t CTL_ZERO_BYTES2 = (size_t)(CW_CMAX + NQCOL) * 4;
constexpr int CW_ITEM = 7680;
constexpr int CW_BAR = 4096;
static_assert((CW_BAR + 3456) * 4 <= (int)CTL_ZERO_BYTES, "barrier words inside the per-call memset");

constexpr int RING_OFF = 0, RING_BYTES = 131072;
constexpr int LDSCTL_OFF = RING_BYTES, MISC_OFF = LDSCTL_OFF + 320;
constexpr int XH_OFF = RING_BYTES + 1024;
constexpr int LDS_BYTES = 147456;
static_assert(MISC_OFF + 128 <= XH_OFF && XH_OFF + 2048 <= LDS_BYTES, "LDS map");

typedef short v4i16_t __attribute__((ext_vector_type(4)));
typedef float f32x2g __attribute__((ext_vector_type(2)));
typedef unsigned u32x2g __attribute__((ext_vector_type(2)));
__device__ __forceinline__ float bflo(unsigned w) { return __uint_as_float(w << 16); }
__device__ __forceinline__ float bfhi(unsigned w) { return __uint_as_float(w & 0xffff0000u); }
__device__ __forceinline__ unsigned cvtpk(float lo, float hi) { return pg8::cvt_pk_bf16(lo, hi); }
__device__ __forceinline__ float wave_sum(float v) {
#pragma unroll
    for (int o = 1; o < 64; o <<= 1) v += __shfl_xor(v, o);
    return v;
}
__device__ __forceinline__ v4i16_t ldtr(LAS const unsigned char* p) { return __builtin_amdgcn_ds_read_tr16_b64_v4i16((LAS v4i16_t*)p); }
__device__ __forceinline__ bf16x8 cat8(v4i16_t a, v4i16_t b) { return (bf16x8){a[0], a[1], a[2], a[3], b[0], b[1], b[2], b[3]}; }
__device__ __forceinline__ float gelu1(float x) { const pg8::f32x2 r = pg8::gelu_pk((pg8::f32x2){x, x}); return r.x; }
__device__ __forceinline__ float silu_mul(float g, float v) { return g * __builtin_amdgcn_rcpf(1.0f + __expf(-g)) * v; }

struct P0Seg { const float* W; bf16* WT; const float* g; float* cmax; int K, N, item; bool up, had; };
__device__ __forceinline__ void p0_load(const P0Seg& sg, int lane, f32x4 (&v)[16]) {
    const int nblk = sg.N >> 6, kb = sg.item / nblk, nb = sg.item - kb * nblk;
    const float* src = sg.W + (size_t)(64 * kb + (lane >> 4)) * sg.N + 64 * nb + 4 * (lane & 15);
#pragma unroll
    for (int j = 0; j < 16; ++j) v[j] = __builtin_nontemporal_load((const GAS f32x4*)(src + (size_t)(4 * j) * sg.N));
}
__device__ __forceinline__ void p0_store(const P0Seg& sg, int lane, f32x4 (&v)[16], LAS unsigned char* T) {
    if (sg.had) {
#pragma unroll
        for (int mask = 1; mask < 16; mask <<= 1)
#pragma unroll
            for (int j = 0; j < 16; ++j) if (!(j & mask)) { const f32x4 a = v[j], b = v[j | mask]; v[j] = a + b; v[j | mask] = a - b; }
#pragma unroll
        for (int sh = 16; sh <= 32; sh <<= 1)
#pragma unroll
            for (int j = 0; j < 16; ++j) { f32x4 p; p.x = __shfl_xor(v[j].x, sh); p.y = __shfl_xor(v[j].y, sh); p.z = __shfl_xor(v[j].z, sh); p.w = __shfl_xor(v[j].w, sh); v[j] = (lane & sh) ? p - v[j] : v[j] + p; }
#pragma unroll
        for (int j = 0; j < 16; ++j) v[j] *= 0.125f;
    }
    const int nblk = sg.N >> 6, kb = sg.item / nblk, nb = sg.item - kb * nblk, k0 = 64 * kb, n0 = 64 * nb;
    const int r0 = !sg.up ? n0 : (n0 < DFF ? 256 * (n0 >> 7) + (n0 & 127) : 256 * ((n0 - DFF) >> 7) + 128 + ((n0 - DFF) & 127));
    float cm0 = 0.f, cm1 = 0.f, cm2 = 0.f, cm3 = 0.f;
#pragma unroll
    for (int j = 0; j < 16; ++j) { const float gk = sg.g ? sg.g[k0 + 4 * j + (lane >> 4)] : 1.0f; u32x2g w; w.x = cvtpk(v[j].x * gk, v[j].y * gk); w.y = cvtpk(v[j].z * gk, v[j].w * gk); *(LAS u32x2g*)(T + (4 * j + (lane >> 4)) * 144 + (lane & 15) * 8) = w;
        cm0 = fmaxf(cm0, fabsf(bflo(w.x))); cm1 = fmaxf(cm1, fabsf(bfhi(w.x))); cm2 = fmaxf(cm2, fabsf(bflo(w.y))); cm3 = fmaxf(cm3, fabsf(bfhi(w.y))); }
    if (sg.cmax) {
        cm0 = fmaxf(cm0, __shfl_xor(cm0, 16)); cm0 = fmaxf(cm0, __shfl_xor(cm0, 32)); cm1 = fmaxf(cm1, __shfl_xor(cm1, 16)); cm1 = fmaxf(cm1, __shfl_xor(cm1, 32));
        cm2 = fmaxf(cm2, __shfl_xor(cm2, 16)); cm2 = fmaxf(cm2, __shfl_xor(cm2, 32)); cm3 = fmaxf(cm3, __shfl_xor(cm3, 16)); cm3 = fmaxf(cm3, __shfl_xor(cm3, 32));
        if (lane < 16) { unsigned* cp = (unsigned*)(sg.cmax + r0 + 4 * lane); atomicMax(cp, __float_as_uint(cm0)); atomicMax(cp + 1, __float_as_uint(cm1)); atomicMax(cp + 2, __float_as_uint(cm2)); atomicMax(cp + 3, __float_as_uint(cm3)); } }
    asm volatile("s_waitcnt lgkmcnt(0)" ::: "memory");
    const int g = lane >> 4, i = lane & 15;
#pragma unroll
    for (int p = 0; p < 8; ++p) { const int kc = g + 4 * (p & 1), nbk = p >> 1;
        LAS const unsigned char* a = T + (8 * kc + (i >> 2)) * 144 + (16 * nbk + 4 * (i & 3)) * 2;
        const bf16x8 o = cat8(ldtr(a), ldtr(a + 4 * 144));
        *(GAS bf16x8*)(sg.WT + (size_t)(r0 + 16 * nbk + i) * sg.K + k0 + 8 * kc) = o; }
    asm volatile("s_waitcnt lgkmcnt(0)" ::: "memory");
}

__device__ __forceinline__ unsigned q8x4(float a, float b, float c, float d, float inv) {
    const float M = 12582912.0f;
    const unsigned ua = __float_as_uint(fmaf(a, inv, M)), ub = __float_as_uint(fmaf(b, inv, M)), uc = __float_as_uint(fmaf(c, inv, M)), ud = __float_as_uint(fmaf(d, inv, M));
    return __builtin_amdgcn_perm(ub, ua, 0x0c0c0400u) | __builtin_amdgcn_perm(ud, uc, 0x04000c0cu);
}
__device__ __forceinline__ float wave_max(float v) {
#pragma unroll
    for (int o = 1; o < 64; o <<= 1) v = fmaxf(v, __shfl_xor(v, o));
    return v;
}
constexpr int ST_RED_OFF = 65536;
__device__ __forceinline__ void p0_strip_up(LAS unsigned char* lds, const float* W, const float* g, unsigned char* WQ, float* sw, int sidx, int par, int lane_in, int wave) {
    int lane = lane_in; asm volatile("" : "+v"(lane));
    const int n0 = 32 * sidx, cg = lane & 7, rg = lane >> 3, kw = 512 * wave;
    const int r0 = n0 < DFF ? 256 * (n0 >> 7) + (n0 & 127) : 256 * ((n0 - DFF) >> 7) + 128 + ((n0 - DFF) & 127);
    unsigned P[16][4][2];
    const float* srcu = W + (size_t)kw * DFF2 + n0; const int lo = 4 * rg * DFF2 + 4 * cg;
    float m0 = 0.f, m1 = 0.f, m2 = 0.f, m3 = 0.f;
#pragma unroll
    for (int jb = 0; jb < 4; ++jb) { f32x4 v[4][4], gk[4];
#pragma unroll
        for (int jj = 0; jj < 4; ++jj) { gk[jj] = *(const GAS f32x4*)(g + kw + 32 * (4 * jb + jj) + 4 * rg);
#pragma unroll
            for (int i = 0; i < 4; ++i) v[jj][i] = __builtin_nontemporal_load((const GAS f32x4*)((srcu + (size_t)(32 * (4 * jb + jj) + i) * DFF2) + lo)); }
#pragma unroll
        for (int jj = 0; jj < 4; ++jj)
#pragma unroll
            for (int i = 0; i < 4; ++i) { const float gg = gk[jj][i]; const unsigned a = cvtpk(v[jj][i].x * gg, v[jj][i].y * gg), b = cvtpk(v[jj][i].z * gg, v[jj][i].w * gg);
                P[4 * jb + jj][i][0] = a; P[4 * jb + jj][i][1] = b;
                m0 = fmaxf(m0, fabsf(bflo(a))); m1 = fmaxf(m1, fabsf(bfhi(a))); m2 = fmaxf(m2, fabsf(bflo(b))); m3 = fmaxf(m3, fabsf(bfhi(b))); }
        asm volatile("" ::: "memory");
    }
#pragma unroll
    for (int sh = 8; sh < 64; sh <<= 1) { m0 = fmaxf(m0, __shfl_xor(m0, sh)); m1 = fmaxf(m1, __shfl_xor(m1, sh)); m2 = fmaxf(m2, __shfl_xor(m2, sh)); m3 = fmaxf(m3, __shfl_xor(m3, sh)); }
    LAS float* red = (LAS float*)(lds + ST_RED_OFF) + par * 256;
    asm volatile("" : "+v"(lane)); const int cg2 = lane & 7, rg2 = lane >> 3;
#pragma unroll
    for (int j = 0; j < 16; ++j)
#pragma unroll
        for (int i = 0; i < 4; ++i) asm volatile("" : "+v"(P[j][i][0]), "+v"(P[j][i][1]));
    if (rg2 == 0) *(LAS f32x4*)(red + wave * 32 + 4 * cg2) = (f32x4){m0, m1, m2, m3};
    __syncthreads();
    f32x4 cm = *(LAS const f32x4*)(red + 4 * cg2);
#pragma unroll
    for (int w = 1; w < 8; ++w) { const f32x4 o = *(LAS const f32x4*)(red + w * 32 + 4 * cg2); cm.x = fmaxf(cm.x, o.x); cm.y = fmaxf(cm.y, o.y); cm.z = fmaxf(cm.z, o.z); cm.w = fmaxf(cm.w, o.w); }
    const float i0 = cm.x > 0.f ? 127.0f / cm.x : 0.f, i1 = cm.y > 0.f ? 127.0f / cm.y : 0.f, i2 = cm.z > 0.f ? 127.0f / cm.z : 0.f, i3 = cm.w > 0.f ? 127.0f / cm.w : 0.f;
    if (wave == 0 && rg2 == 0) *(GAS f32x4*)(sw + r0 + 4 * cg2) = cm * (1.0f / 127.0f);
    LAS unsigned char* T = lds + wave * 8192;
#pragma unroll
    for (int jh = 0; jh < 2; ++jh) {
#pragma unroll
        for (int jp = 0; jp < 8; ++jp) { const int j = 8 * jh + jp, d = (8 * jp + rg2) ^ (cg2 << 2);
            LAS unsigned* tp = (LAS unsigned*)(T + (4 * cg2) * 256 + 4 * d);
            tp[0] = q8x4(bflo(P[j][0][0]), bflo(P[j][1][0]), bflo(P[j][2][0]), bflo(P[j][3][0]), i0);
            tp[64] = q8x4(bfhi(P[j][0][0]), bfhi(P[j][1][0]), bfhi(P[j][2][0]), bfhi(P[j][3][0]), i1);
            tp[128] = q8x4(bflo(P[j][0][1]), bflo(P[j][1][1]), bflo(P[j][2][1]), bflo(P[j][3][1]), i2);
            tp[192] = q8x4(bfhi(P[j][0][1]), bfhi(P[j][1][1]), bfhi(P[j][2][1]), bfhi(P[j][3][1]), i3); }
        asm volatile("s_waitcnt lgkmcnt(0)" ::: "memory");
#pragma unroll
        for (int t = 0; t < 8; ++t) { const int id = lane + 64 * t, row = id >> 4, Q = id & 15;
            const v4u val = *(LAS const v4u*)(T + row * 256 + 16 * (Q ^ (row >> 2)));
            *(GAS v4u*)(WQ + (size_t)(r0 + row) * D + kw + 256 * jh + 16 * Q) = val; }
        asm volatile("s_waitcnt lgkmcnt(0)" ::: "memory");
    }
}
__device__ __forceinline__ void ld8(const float* row, int chunk, float (&o)[8]) { const f32x4 a = *(const GAS f32x4*)(row + 8 * chunk), b = *(const GAS f32x4*)(row + 8 * chunk + 4);
    o[0] = a.x; o[1] = a.y; o[2] = a.z; o[3] = a.w; o[4] = b.x; o[5] = b.y; o[6] = b.z; o[7] = b.w; }
__device__ __forceinline__ void up8(const v4u x, float (&o)[8]) { o[0] = bflo(x.x); o[1] = bfhi(x.x); o[2] = bflo(x.y); o[3] = bfhi(x.y); o[4] = bflo(x.z); o[5] = bfhi(x.z); o[6] = bflo(x.w); o[7] = bfhi(x.w); }
__device__ __forceinline__ void ld8(const bf16* row, int chunk, float (&o)[8]) { up8(*(const GAS v4u*)(row + 8 * chunk), o); }
__device__ __forceinline__ void st8(float* row, int chunk, const float (&v)[8]) { *(GAS f32x4*)(row + 8 * chunk) = (f32x4){v[0], v[1], v[2], v[3]}; *(GAS f32x4*)(row + 8 * chunk + 4) = (f32x4){v[4], v[5], v[6], v[7]}; }
__device__ __forceinline__ void st8(bf16* row, int chunk, const float (&v)[8]) { v4u w; w.x = cvtpk(v[0], v[1]); w.y = cvtpk(v[2], v[3]); w.z = cvtpk(v[4], v[5]); w.w = cvtpk(v[6], v[7]); *(GAS v4u*)(row + 8 * chunk) = w; }
template <bool NORMED> __device__ __forceinline__ void first_row(const float* xrow, bf16* xb, float* r2, int lane, unsigned char* xq = nullptr, float* rq = nullptr) {
    float v[8][8]; float ss = 0.f;
#pragma unroll
    for (int j = 0; j < 8; ++j) { ld8(xrow, lane + 64 * j, v[j]);
#pragma unroll
        for (int e = 0; e < 8; ++e) ss += v[j][e] * v[j][e]; }
    const float r = 1.0f / sqrtf(wave_sum(ss) * (1.0f / D) + NORM_EPS);
    if (!NORMED && lane == 0) *r2 = r;
    if (xq) { float mx = 0.f;
#pragma unroll
        for (int j = 0; j < 8; ++j)
#pragma unroll
            for (int e = 0; e < 8; ++e) mx = fmaxf(mx, fabsf(__uint_as_float(f2bf(v[j][e]) << 16)));
        mx = wave_max(mx); const float inv = mx > 0.f ? 127.0f / mx : 0.f; if (lane == 0) *rq = r * mx * (1.0f / 127.0f);
#pragma unroll
        for (int j = 0; j < 8; ++j) { float t[8];
#pragma unroll
            for (int e = 0; e < 8; ++e) t[e] = __uint_as_float(f2bf(v[j][e]) << 16);
            u32x2g q; q.x = q8x4(t[0], t[1], t[2], t[3], inv); q.y = q8x4(t[4], t[5], t[6], t[7], inv); *(GAS u32x2g*)(xq + 8 * (lane + 64 * j)) = q; } }
#pragma unroll
    for (int j = 0; j < 8; ++j) { if (NORMED) {
#pragma unroll
            for (int e = 0; e < 8; ++e) v[j][e] *= r; }
        st8(xb, lane + 64 * j, v[j]); }
}
template <typename TY, typename TXI, typename TXO>
__device__ __forceinline__ void resid_norm_row(const TY* yrow, const TXI* xin, const float* gpost, TXO* xout, float* r2, bf16* hn, int lane, unsigned char* hq = nullptr, float* hs = nullptr) {
    float v[8][8]; float ss = 0.f;
#pragma unroll
    for (int j = 0; j < 8; ++j) { ld8(yrow, lane + 64 * j, v[j]);
#pragma unroll
        for (int e = 0; e < 8; ++e) ss += v[j][e] * v[j][e]; }
    const float r = 1.0f / sqrtf(wave_sum(ss) * (1.0f / D) + NORM_EPS);
    float s2 = 0.f;
#pragma unroll
    for (int j = 0; j < 8; ++j) { float xx[8], gg[8]; ld8(xin, lane + 64 * j, xx); ld8(gpost, lane + 64 * j, gg);
#pragma unroll
        for (int e = 0; e < 8; ++e) { v[j][e] = xx[e] + v[j][e] * r * gg[e]; s2 += v[j][e] * v[j][e]; }
        st8(xout, lane + 64 * j, v[j]); }
    if (r2 || hn) {
        const float rr = 1.0f / sqrtf(wave_sum(s2) * (1.0f / D) + NORM_EPS);
        if (r2 && lane == 0) *r2 = rr;
        if (hn) {
#pragma unroll
            for (int j = 0; j < 8; ++j) { float o[8];
#pragma unroll
                for (int e = 0; e < 8; ++e) o[e] = v[j][e] * rr;
                st8(hn, lane + 64 * j, o); }
            if (hq) { float mx = 0.f;
#pragma unroll
                for (int j = 0; j < 8; ++j)
#pragma unroll
                    for (int e = 0; e < 8; ++e) mx = fmaxf(mx, fabsf(__uint_as_float(f2bf(v[j][e] * rr) << 16)));
                mx = wave_max(mx); const float inv = mx > 0.f ? 127.0f / mx : 0.f; if (lane == 0) *hs = mx * (1.0f / 127.0f);
#pragma unroll
                for (int j = 0; j < 8; ++j) { float t[8];
#pragma unroll
                    for (int e = 0; e < 8; ++e) t[e] = __uint_as_float(f2bf(v[j][e] * rr) << 16);
                    u32x2g q; q.x = q8x4(t[0], t[1], t[2], t[3], inv); q.y = q8x4(t[4], t[5], t[6], t[7], inv); *(GAS u32x2g*)(hq + 8 * (lane + 64 * j)) = q; } } }
    }
}
template <typename TXO, bool QUANT = false> __device__ __forceinline__ void resid_norm_row2(const bf16* ya, const bf16* yb, const bf16* xia, const bf16* xib, TXO* xa, TXO* xb, const float* gpost, float* r2a, float* r2b, int lane,
                                                                                            unsigned char* xqa = nullptr, unsigned char* xqb = nullptr, float* rqa = nullptr, float* rqb = nullptr, unsigned char* cqa = nullptr, unsigned char* cqb = nullptr, float* csa = nullptr, float* csb = nullptr) {
#define CH2(j) (QUANT ? 2 * lane + ((j) & 1) + 128 * ((j) >> 1) : lane + 64 * (j))
    v4u yra[8], yrb[8], xra[8], xrb[8];
#pragma unroll
    for (int j = 0; j < 8; ++j) { yra[j] = *(const GAS v4u*)(ya + 8 * (CH2(j))); yrb[j] = *(const GAS v4u*)(yb + 8 * (CH2(j))); }
#pragma unroll
    for (int j = 0; j < 8; ++j) { xra[j] = *(const GAS v4u*)(xia + 8 * (CH2(j))); xrb[j] = *(const GAS v4u*)(xib + 8 * (CH2(j))); }
    float sa = 0.f, sb = 0.f;
#pragma unroll
    for (int j = 0; j < 8; ++j) { float t[8]; up8(yra[j], t);
#pragma unroll
        for (int e = 0; e < 8; ++e) sa += t[e] * t[e];
        up8(yrb[j], t);
#pragma unroll
        for (int e = 0; e < 8; ++e) sb += t[e] * t[e]; }
    const float ra = 1.0f / sqrtf(wave_sum(sa) * (1.0f / D) + NORM_EPS), rb = 1.0f / sqrtf(wave_sum(sb) * (1.0f / D) + NORM_EPS);
#pragma unroll
    for (int j = 0; j < 8; ++j) asm volatile("" : "+v"(yra[j]), "+v"(yrb[j]));
    float qa = 0.f, qb = 0.f;
#pragma unroll
    for (int j = 0; j < 8; ++j) { float gg[8], y[8], x[8], o[8]; ld8(gpost, CH2(j), gg);
        up8(yra[j], y); up8(xra[j], x);
#pragma unroll
        for (int e = 0; e < 8; ++e) { o[e] = x[e] + y[e] * ra * gg[e]; qa += o[e] * o[e]; }
        st8(xa, CH2(j), o); if (QUANT) { xra[j].x = cvtpk(o[0], o[1]); xra[j].y = cvtpk(o[2], o[3]); xra[j].z = cvtpk(o[4], o[5]); xra[j].w = cvtpk(o[6], o[7]); }
        up8(yrb[j], y); up8(xrb[j], x);
#pragma unroll
        for (int e = 0; e < 8; ++e) { o[e] = x[e] + y[e] * rb * gg[e]; qb += o[e] * o[e]; }
        st8(xb, CH2(j), o); if (QUANT) { xrb[j].x = cvtpk(o[0], o[1]); xrb[j].y = cvtpk(o[2], o[3]); xrb[j].z = cvtpk(o[4], o[5]); xrb[j].w = cvtpk(o[6], o[7]); } }
    if (r2a) { const float r2av = 1.0f / sqrtf(wave_sum(qa) * (1.0f / D) + NORM_EPS), r2bv = 1.0f / sqrtf(wave_sum(qb) * (1.0f / D) + NORM_EPS);
        if (lane == 0) { *r2a = r2av; *r2b = r2bv; }
        if (QUANT) { float ma = 0.f, mb = 0.f;
#pragma unroll
            for (int j = 0; j < 8; ++j) { float t[8]; up8(xra[j], t);
#pragma unroll
                for (int e = 0; e < 8; ++e) ma = fmaxf(ma, fabsf(t[e]));
                up8(xrb[j], t);
#pragma unroll
                for (int e = 0; e < 8; ++e) mb = fmaxf(mb, fabsf(t[e])); }
            ma = wave_max(ma); mb = wave_max(mb);
            const float ia = ma > 0.f ? 127.0f / ma : 0.f, ib = mb > 0.f ? 127.0f / mb : 0.f;
            if (lane == 0) { *rqa = r2av * ma * (1.0f / 127.0f); *rqb = r2bv * mb * (1.0f / 127.0f); if (cqa) *csa = r2av * ma * (1.0f / 127.0f); if (cqb) *csb = r2bv * mb * (1.0f / 127.0f); }
#pragma unroll
            for (int jj = 0; jj < 4; ++jj) { v4u qa4, qb4;
#pragma unroll
                for (int h = 0; h < 2; ++h) { const int j = 2 * jj + h; float t[8]; up8(xra[j], t);
                    if (h == 0) { qa4.x = q8x4(t[0], t[1], t[2], t[3], ia); qa4.y = q8x4(t[4], t[5], t[6], t[7], ia); } else { qa4.z = q8x4(t[0], t[1], t[2], t[3], ia); qa4.w = q8x4(t[4], t[5], t[6], t[7], ia); }
                    up8(xrb[j], t);
                    if (h == 0) { qb4.x = q8x4(t[0], t[1], t[2], t[3], ib); qb4.y = q8x4(t[4], t[5], t[6], t[7], ib); } else { qb4.z = q8x4(t[0], t[1], t[2], t[3], ib); qb4.w = q8x4(t[4], t[5], t[6], t[7], ib); }
                    }
                *(GAS v4u*)(xqa + 8 * CH2(2 * jj)) = qa4; *(GAS v4u*)(xqb + 8 * CH2(2 * jj)) = qb4;
                if (cqa) *(GAS v4u*)(cqa + 8 * CH2(2 * jj)) = qa4; if (cqb) *(GAS v4u*)(cqb + 8 * CH2(2 * jj)) = qb4; } }
    }
}
#undef CH2
__device__ __forceinline__ void final_row2(const bf16* ya, const bf16* yb, const bf16* xia, const bf16* xib, float* oa, float* ob, const float* gpost, int lane) {
    u32x2g yra[16], yrb[16], xra[16], xrb[16];
#pragma unroll
    for (int j = 0; j < 16; ++j) { const int e = 4 * (lane + 64 * j); yra[j] = *(const GAS u32x2g*)(ya + e); yrb[j] = *(const GAS u32x2g*)(yb + e); }
#pragma unroll
    for (int j = 0; j < 16; ++j) { const int e = 4 * (lane + 64 * j); xra[j] = *(const GAS u32x2g*)(xia + e); xrb[j] = *(const GAS u32x2g*)(xib + e); }
    float sa = 0.f, sb = 0.f;
#pragma unroll
    for (int j = 0; j < 16; ++j) { const float a0 = bflo(yra[j].x), a1 = bfhi(yra[j].x), a2 = bflo(yra[j].y), a3 = bfhi(yra[j].y); sa += (a0 * a0 + a1 * a1) + (a2 * a2 + a3 * a3);
        const float b0 = bflo(yrb[j].x), b1 = bfhi(yrb[j].x), b2 = bflo(yrb[j].y), b3 = bfhi(yrb[j].y); sb += (b0 * b0 + b1 * b1) + (b2 * b2 + b3 * b3); }
    const float ra = 1.0f / sqrtf(wave_sum(sa) * (1.0f / D) + NORM_EPS), rb = 1.0f / sqrtf(wave_sum(sb) * (1.0f / D) + NORM_EPS);
#pragma unroll
    for (int j = 0; j < 16; ++j) asm volatile("" : "+v"(yra[j]), "+v"(yrb[j]));
#pragma unroll
    for (int j = 0; j < 16; ++j) { const int e = 4 * (lane + 64 * j); const f32x4 gg = *(const GAS f32x4*)(gpost + e);
        f32x4 o; o.x = bflo(xra[j].x) + bflo(yra[j].x) * ra * gg.x; o.y = bfhi(xra[j].x) + bfhi(yra[j].x) * ra * gg.y; o.z = bflo(xra[j].y) + bflo(yra[j].y) * ra * gg.z; o.w = bfhi(xra[j].y) + bfhi(yra[j].y) * ra * gg.w;
        *(GAS f32x4*)(oa + e) = o;
        o.x = bflo(xrb[j].x) + bflo(yrb[j].x) * rb * gg.x; o.y = bfhi(xrb[j].x) + bfhi(yrb[j].x) * rb * gg.y; o.z = bflo(xrb[j].y) + bflo(yrb[j].y) * rb * gg.z; o.w = bfhi(xrb[j].y) + bfhi(yrb[j].y) * rb * gg.w;
        *(GAS f32x4*)(ob + e) = o; }
}

__device__ __forceinline__ float dpp_quad_x1(float x) { return __int_as_float(__builtin_amdgcn_update_dpp(0, __float_as_int(x), 0xB1, 0xf, 0xf, true)); }
__device__ __forceinline__ float dpp_quad_x2(float x) { return __int_as_float(__builtin_amdgcn_update_dpp(0, __float_as_int(x), 0x4E, 0xf, 0xf, true)); }
__device__ __forceinline__ void act_row_load(v4u (&x)[11][2], const bf16* arow, int lane) {
#pragma unroll
    for (int i = 0; i < 11; ++i) { const int c = lane + 64 * i;
        if (i < 10 || lane < 48) { x[i][0] = *(const GAS v4u*)(arow + 16 * c); x[i][1] = *(const GAS v4u*)(arow + 16 * c + 8); } else { x[i][0] = (v4u){0u, 0u, 0u, 0u}; x[i][1] = (v4u){0u, 0u, 0u, 0u}; } }
}
template <bool QUANT> __device__ __forceinline__ void act_row_proc(v4u (&x)[11][2], unsigned char* qrow, float* sa, bf16* orow, int lane);
template <bool QUANT> __device__ __forceinline__ void act_rot_row(const bf16* arow, unsigned char* qrow, float* sa, bf16* orow, int lane) { v4u x[11][2]; act_row_load(x, arow, lane); act_row_proc<QUANT>(x, qrow, sa, orow, lane); }
__device__ __forceinline__ void act_rot_rows(const bf16* ACT, unsigned char* ACTQ, float* SA, int r0, int r_end, int stride, int lane) {
    if (r0 >= r_end) return;
    v4u xa[11][2], xb[11][2]; act_row_load(xa, ACT + (size_t)r0 * DFF, lane);
    for (int r = r0; r < r_end; r += 2 * stride) { const int r1 = r + stride, r2 = r + 2 * stride;
        if (r1 < r_end) act_row_load(xb, ACT + (size_t)r1 * DFF, lane);
        act_row_proc<true>(xa, ACTQ + (size_t)r * DFF, SA + r, (bf16*)nullptr, lane);
        if (r2 < r_end) act_row_load(xa, ACT + (size_t)r2 * DFF, lane);
        if (r1 < r_end) act_row_proc<true>(xb, ACTQ + (size_t)r1 * DFF, SA + r1, (bf16*)nullptr, lane); }
}
template <bool QUANT> __device__ __forceinline__ void act_row_proc(v4u (&x)[11][2], unsigned char* qrow, float* sa, bf16* orow, int lane) {
    float mx = 0.f; const unsigned sm1 = (unsigned)(lane & 1) << 31, sm2 = (unsigned)(lane & 2) << 30;
#pragma unroll
    for (int i = 0; i < 11; ++i) { float t[16];
        { float a[8]; up8(x[i][0], a);
#pragma unroll
          for (int e = 0; e < 8; ++e) t[e] = a[e];
          up8(x[i][1], a);
#pragma unroll
          for (int e = 0; e < 8; ++e) t[8 + e] = a[e]; }
#pragma unroll
        for (int mask = 1; mask < 16; mask <<= 1)
#pragma unroll
            for (int e = 0; e < 16; ++e) if (!(e & mask)) { const float a = t[e], b = t[e | mask]; t[e] = a + b; t[e | mask] = a - b; }
#pragma unroll
        for (int e = 0; e < 16; ++e) t[e] = dpp_quad_x1(t[e]) + __uint_as_float(__float_as_uint(t[e]) ^ sm1);
#pragma unroll
        for (int e = 0; e < 16; ++e) t[e] = dpp_quad_x2(t[e]) + __uint_as_float(__float_as_uint(t[e]) ^ sm2);
        if (QUANT) {
#pragma unroll
            for (int e = 0; e < 16; e += 2) mx = fmaxf(mx, fmaxf(fabsf(t[e]), fabsf(t[e + 1])));
        } else {
#pragma unroll
            for (int e = 0; e < 16; ++e) t[e] *= 0.125f; }
        x[i][0].x = cvtpk(t[0], t[1]); x[i][0].y = cvtpk(t[2], t[3]); x[i][0].z = cvtpk(t[4], t[5]); x[i][0].w = cvtpk(t[6], t[7]);
        x[i][1].x = cvtpk(t[8], t[9]); x[i][1].y = cvtpk(t[10], t[11]); x[i][1].z = cvtpk(t[12], t[13]); x[i][1].w = cvtpk(t[14], t[15]);
        if (!QUANT && (i < 10 || lane < 48)) { const int c = lane + 64 * i; *(GAS v4u*)(orow + 16 * c) = x[i][0]; *(GAS v4u*)(orow + 16 * c + 8) = x[i][1]; } }
    if (QUANT) { mx = wave_max(mx); const float inv = mx > 0.f ? 127.0f / mx : 0.f; if (lane == 0) *sa = mx * (0.125f / 127.0f);
#pragma unroll
        for (int i = 0; i < 11; ++i) { float a[8], b[8]; up8(x[i][0], a); up8(x[i][1], b); v4u q;
            q.x = q8x4(a[0], a[1], a[2], a[3], inv); q.y = q8x4(a[4], a[5], a[6], a[7], inv); q.z = q8x4(b[0], b[1], b[2], b[3], inv); q.w = q8x4(b[4], b[5], b[6], b[7], inv);
            if (i < 10 || lane < 48) *(GAS v4u*)(qrow + 16 * (lane + 64 * i)) = q; } }
}
template <int NT, int RT, class RowOf, class Epi> __device__ __forceinline__ void skinny_gemm(LAS unsigned char* lds, const bf16* A, const bf16* Bt, int K, int t_begin, int t_end, int t_stride,
                                                                                      const RowOf& rowof, const Epi& epi, int tid, int wave, int lane) {
    constexpr int CT = NT / 16, NR = 16 * RT;
    const int fr = lane & 15, fq = lane >> 4, kw = K / 8, k0 = wave * kw;
    LAS float* red = (LAS float*)lds; LAS float* sums = red + 8 * NR * NT;
    for (int tile = t_begin; tile < t_end; tile += t_stride) {
        f32x4 acc[RT][CT];
#pragma unroll
        for (int r = 0; r < RT; ++r)
#pragma unroll
            for (int c = 0; c < CT; ++c) acc[r][c] = (f32x4){0.f, 0.f, 0.f, 0.f};
        const bf16* ap = A + (size_t)fr * K + k0 + 8 * fq; const bf16* bp[CT];
#pragma unroll
        for (int c = 0; c < CT; ++c) bp[c] = Bt + (size_t)(rowof(tile, c) + fr) * K + k0 + 8 * fq;
#pragma unroll 8
        for (int k = 0; k < kw; k += 32) {
            bf16x8 a[RT];
#pragma unroll
            for (int r = 0; r < RT; ++r) a[r] = *(const GAS bf16x8*)(ap + (size_t)(16 * r) * K + k);
#pragma unroll
            for (int c = 0; c < CT; ++c) { const bf16x8 b = *(const GAS bf16x8*)(bp[c] + k);
#pragma unroll
                for (int r = 0; r < RT; ++r) acc[r][c] = __builtin_amdgcn_mfma_f32_16x16x32_bf16(a[r], b, acc[r][c], 0, 0, 0); }
        }
#pragma unroll
        for (int r = 0; r < RT; ++r)
#pragma unroll
            for (int c = 0; c < CT; ++c)
#pragma unroll
                for (int i = 0; i < 4; ++i) red[(wave * NR + 16 * r + 4 * fq + i) * NT + 16 * c + fr] = acc[r][c][i];
        __syncthreads();
        for (int e = tid; e < NR * NT; e += NWAVES * 64) { float sm = 0.f;
#pragma unroll
            for (int w = 0; w < 8; ++w) sm += red[w * NR * NT + e];
            sums[e] = sm; }
        __syncthreads();
        for (int t = tid; t < NR * NT; t += NWAVES * 64) epi(tile, t, sums);
    }
}
__device__ __forceinline__ bf16x8 i8x8_to_bf16(unsigned lo, unsigned hi) {
    v4u w; w.x = cvtpk((float)(signed char)(lo), (float)(signed char)(lo >> 8)); w.y = cvtpk((float)(signed char)(lo >> 16), (float)((int)lo >> 24));
    w.z = cvtpk((float)(signed char)(hi), (float)(signed char)(hi >> 8)); w.w = cvtpk((float)(signed char)(hi >> 16), (float)((int)hi >> 24));
    return __builtin_bit_cast(bf16x8, w);
}
template <int NT, int RT, class RowOf, class Epi> __device__ __forceinline__ void skinny_gemm_w8(LAS unsigned char* lds, const bf16* A, const unsigned char* Bq, int K, int t_begin, int t_end, int t_stride,
                                                                                         const RowOf& rowof, const Epi& epi, int tid, int wave, int lane) {
    constexpr int CT = NT / 16, NR = 16 * RT;
    const int fr = lane & 15, fq = lane >> 4, nblk = K >> 6, base = nblk >> 3, rem = nblk & 7, nb = base + (wave < rem ? 1 : 0), k0 = 64 * (wave * base + (wave < rem ? wave : rem));
    LAS float* red = (LAS float*)lds; LAS float* sums = red + 8 * NR * NT;
    for (int tile = t_begin; tile < t_end; tile += t_stride) {
        f32x4 acc[RT][CT];
#pragma unroll
        for (int r = 0; r < RT; ++r)
#pragma unroll
            for (int c = 0; c < CT; ++c) acc[r][c] = (f32x4){0.f, 0.f, 0.f, 0.f};
        const bf16* ap = A + (size_t)fr * K + k0 + 16 * fq; const unsigned char* bp[CT];
#pragma unroll
        for (int c = 0; c < CT; ++c) bp[c] = Bq + (size_t)(rowof(tile, c) + fr) * K + k0 + 16 * fq;
#pragma unroll 4
        for (int s = 0; s < nb; ++s) { const int k = 64 * s;
            bf16x8 a[RT][2];
#pragma unroll
            for (int r = 0; r < RT; ++r) { a[r][0] = *(const GAS bf16x8*)(ap + (size_t)(16 * r) * K + k); a[r][1] = *(const GAS bf16x8*)(ap + (size_t)(16 * r) * K + k + 8); }
#pragma unroll
            for (int c = 0; c < CT; ++c) { const v4u w = *(const GAS v4u*)(bp[c] + k); const bf16x8 b0 = i8x8_to_bf16(w.x, w.y), b1 = i8x8_to_bf16(w.z, w.w);
#pragma unroll
                for (int r = 0; r < RT; ++r) { acc[r][c] = __builtin_amdgcn_mfma_f32_16x16x32_bf16(a[r][0], b0, acc[r][c], 0, 0, 0); acc[r][c] = __builtin_amdgcn_mfma_f32_16x16x32_bf16(a[r][1], b1, acc[r][c], 0, 0, 0); } }
        }
#pragma unroll
        for (int r = 0; r < RT; ++r)
#pragma unroll
            for (int c = 0; c < CT; ++c)
#pragma unroll
                for (int i = 0; i < 4; ++i) red[(wave * NR + 16 * r + 4 * fq + i) * NT + 16 * c + fr] = acc[r][c][i];
        __syncthreads();
        for (int e = tid; e < NR * NT; e += NWAVES * 64) { float sm = 0.f;
#pragma unroll
            for (int w = 0; w < 8; ++w) sm += red[w * NR * NT + e];
            sums[e] = sm; }
        __syncthreads();
        for (int t = tid; t < NR * NT; t += NWAVES * 64) epi(tile, t, sums);
    }
}
template <int NT> __device__ __forceinline__ void skinny_plain_w8(LAS unsigned char* lds, const bf16* A, const unsigned char* Bq, int K, float* out, int ldo, const float* scale,
                                                                  int t_begin, int t_end, int t_stride, int tid, int wave, int lane) {
    auto rowof = [](int tile, int c) { return tile * NT + 16 * c; };
    auto epi = [=](int tile, int t, LAS const float* sums) { const int row = t / NT, col = tile * NT + t % NT; out[(size_t)row * ldo + col] = sums[t] * scale[col]; };
    skinny_gemm_w8<NT, 2>(lds, A, Bq, K, t_begin, t_end, t_stride, rowof, epi, tid, wave, lane);
}
typedef int v4i32_t __attribute__((ext_vector_type(4)));
template <int NT, int RT, class RowOf, class Epi> __device__ __forceinline__ void skinny_i8_resident(LAS unsigned char* lds, const unsigned char* Aq, const unsigned char* Bq, int t_begin, int t_end, int t_stride,
                                                                                             const RowOf& rowof, const Epi& epi, int tid, int wave, int lane) {
    constexpr int CT = NT / 16, NR = 16 * RT, K = 4096;
    const int fr = lane & 15, fq = lane >> 4, k0 = 512 * wave + 16 * fq;
    LAS float* red = (LAS float*)lds; LAS float* sums = red + 8 * NR * NT;
    if (t_begin >= t_end) return;
    v4i32_t a[RT][8], b[CT][8];
#pragma unroll
    for (int r = 0; r < RT; ++r)
#pragma unroll
        for (int k = 0; k < 8; ++k) a[r][k] = *(const GAS v4i32_t*)(Aq + (size_t)(16 * r + fr) * K + k0 + 64 * k);
#pragma unroll
    for (int c = 0; c < CT; ++c)
#pragma unroll
        for (int k = 0; k < 8; ++k) b[c][k] = *(const GAS v4i32_t*)(Bq + (size_t)(rowof(t_begin, c) + fr) * K + k0 + 64 * k);
    for (int tile = t_begin; tile < t_end; tile += t_stride) {
        v4i32_t acc[RT][CT];
#pragma unroll
        for (int r = 0; r < RT; ++r)
#pragma unroll
            for (int c = 0; c < CT; ++c) acc[r][c] = (v4i32_t){0, 0, 0, 0};
#pragma unroll
        for (int k = 0; k < 8; ++k)
#pragma unroll
            for (int c = 0; c < CT; ++c)
#pragma unroll
                for (int r = 0; r < RT; ++r) acc[r][c] = __builtin_amdgcn_mfma_i32_16x16x64_i8(a[r][k], b[c][k], acc[r][c], 0, 0, 0);
        const int nxt = tile + t_stride;
        if (nxt < t_end) {
#pragma unroll
            for (int c = 0; c < CT; ++c)
#pragma unroll
                for (int k = 0; k < 8; ++k) b[c][k] = *(const GAS v4i32_t*)(Bq + (size_t)(rowof(nxt, c) + fr) * K + k0 + 64 * k); }
#pragma unroll
        for (int r = 0; r < RT; ++r)
#pragma unroll
            for (int c = 0; c < CT; ++c)
#pragma unroll
                for (int i = 0; i < 4; ++i) red[(wave * NR + 16 * r + 4 * fq + i) * NT + 16 * c + fr] = (float)acc[r][c][i];
        __syncthreads();
        for (int e = tid; e < NR * NT; e += NWAVES * 64) { float sm = 0.f;
#pragma unroll
            for (int w = 0; w < 8; ++w) sm += red[w * NR * NT + e];
            sums[e] = sm; }
        __syncthreads();
        for (int t = tid; t < NR * NT; t += NWAVES * 64) epi(tile, t, sums);
    }
}
template <int NT, int RT, class RowOf, class Epi> __device__ __forceinline__ void skinny_i8(LAS unsigned char* lds, const unsigned char* Aq, const unsigned char* Bq, int K, int t_begin, int t_end, int t_stride,
                                                                                     const RowOf& rowof, const Epi& epi, int tid, int wave, int lane) {
    constexpr int CT = NT / 16, NR = 16 * RT;
    const int fr = lane & 15, fq = lane >> 4, nblk = K >> 6, base = nblk >> 3, rem = nblk & 7, nb = base + (wave < rem ? 1 : 0), k0 = 64 * (wave * base + (wave < rem ? wave : rem)) + 16 * fq;
    LAS float* red = (LAS float*)lds; LAS float* sums = red + 8 * NR * NT;
    for (int tile = t_begin; tile < t_end; tile += t_stride) {
        v4i32_t acc[RT][CT];
#pragma unroll
        for (int r = 0; r < RT; ++r)
#pragma unroll
            for (int c = 0; c < CT; ++c) acc[r][c] = (v4i32_t){0, 0, 0, 0};
        const unsigned char* ap = Aq + (size_t)fr * K + k0; const unsigned char* bp[CT];
#pragma unroll
        for (int c = 0; c < CT; ++c) bp[c] = Bq + (size_t)(rowof(tile, c) + fr) * K + k0;
#pragma unroll 8
        for (int s = 0; s < nb; ++s) { v4i32_t a[RT];
#pragma unroll
            for (int r = 0; r < RT; ++r) a[r] = *(const GAS v4i32_t*)(ap + (size_t)(16 * r) * K + 64 * s);
#pragma unroll
            for (int c = 0; c < CT; ++c) { const v4i32_t b = *(const GAS v4i32_t*)(bp[c] + 64 * s);
#pragma unroll
                for (int r = 0; r < RT; ++r) acc[r][c] = __builtin_amdgcn_mfma_i32_16x16x64_i8(a[r], b, acc[r][c], 0, 0, 0); } }
#pragma unroll
        for (int r = 0; r < RT; ++r)
#pragma unroll
            for (int c = 0; c < CT; ++c)
#pragma unroll
                for (int i = 0; i < 4; ++i) red[(wave * NR + 16 * r + 4 * fq + i) * NT + 16 * c + fr] = (float)acc[r][c][i];
        __syncthreads();
        for (int e = tid; e < NR * NT; e += NWAVES * 64) { float sm = 0.f;
#pragma unroll
            for (int w = 0; w < 8; ++w) sm += red[w * NR * NT + e];
            sums[e] = sm; }
        __syncthreads();
        for (int t = tid; t < NR * NT; t += NWAVES * 64) epi(tile, t, sums);
    }
}
template <int NT, int ACT> __device__ __forceinline__ void skinny_plain(LAS unsigned char* lds, const bf16* A, const bf16* Bt, int N, int K, float* out, int ldo, const float* bias,
                                                                        int t_begin, int t_end, int t_stride, int tid, int wave, int lane) {
    auto rowof = [](int tile, int c) { return tile * NT + 16 * c; };
    auto epi = [=](int tile, int t, LAS const float* sums) { const int row = t / NT, col = tile * NT + t % NT; float v = sums[t]; if (bias) v += bias[col]; if (ACT == 1) v = gelu1(v); out[(size_t)row * ldo + col] = v; };
    (void)N; skinny_gemm<NT, 2>(lds, A, Bt, K, t_begin, t_end, t_stride, rowof, epi, tid, wave, lane);
}
__device__ __forceinline__ void skinny_assign(int ntiles, int nwg, int q, int bx, int G, int& t_begin, int& t_end, int& t_stride) {
    const int rem = nwg % G;
    if (rem == 0) { t_begin = bx; t_end = ntiles; t_stride = G; return; }
    const int nidle = G - rem, nit = ntiles < nidle * q ? ntiles : nidle * q;
    if (bx >= rem) { t_begin = bx - rem; t_end = nit; t_stride = nidle; } else { t_begin = nit + bx; t_end = ntiles; t_stride = rem; }
}

constexpr int GT_VS = 544, GT_WS = 272;
constexpr int GT_OFF_V = 0, GT_OFF_W = 128 * GT_VS, GT_OFF_MR = GT_OFF_W + 128 * GT_WS;
static_assert(GT_OFF_MR + 1024 <= RING_BYTES, "gating LDS");
__device__ __forceinline__ void gate_units(LAS unsigned char* lds, int u0, int u_end, int u_stride, const bf16* U, const bf16* V, const float* vstat, const float* ln_g, const float* ln_b,
                                           const float* w_s, const float* b_s, bf16* GATED, float* gvp, int tid_in, int wave, int lane_in) {
    if (u0 >= u_end) return;
    int tid = tid_in; asm volatile("" : "+v"(tid));
    LAS unsigned char* Vs = lds + GT_OFF_V; LAS unsigned char* Ws = lds + GT_OFF_W; LAS f32x2g* MR = (LAS f32x2g*)(lds + GT_OFF_MR);
    v4u vraw[8], uraw[8]; f32x4 st[8];
    auto ld_v = [&](int u) { const int t0 = (u >> 4) * 128, g = u & 15;
#pragma unroll
        for (int i = 0; i < 8; ++i) vraw[i] = *(const GAS v4u*)(V + (size_t)(t0 + (tid >> 5) + 16 * i) * D + g * 256 + (tid & 31) * 8); };
    auto ld_u = [&](int u) { const int t0 = (u >> 4) * 128, g = u & 15;
#pragma unroll
        for (int i = 0; i < 8; ++i) uraw[i] = *(const GAS v4u*)(U + (size_t)(t0 + (tid >> 5) + 16 * i) * D + g * 256 + (tid & 31) * 8); };
    auto ld_st = [&](int u) { const GAS f32x4* p = (const GAS f32x4*)(vstat + ((size_t)((u >> 4) * 128 + (tid >> 2)) * 64 + 16 * (tid & 3)) * 2);
#pragma unroll
        for (int j = 0; j < 8; ++j) st[j] = p[j]; };
    ld_st(u0); ld_v(u0); ld_u(u0);
    int gcur = -1; f32x4 g0, g1, b0, b1; float bb[8];
    for (int u = u0; u < u_end; u += u_stride) {
        tid = tid_in; asm volatile("" : "+v"(tid)); const int lane = tid & 63, fr = lane & 15, fq = lane >> 4, ch = tid & 31; (void)lane_in;
        const int cidx = u >> 4, g = u & 15, t0 = cidx * 128, un = u + u_stride; const bool hn = un < u_end;
        { const int tok = tid >> 2, qd = tid & 3; float sm = 0.f, q = 0.f;
#pragma unroll
          for (int j = 0; j < 8; ++j) { const f32x4 x = st[j]; sm += x.x + x.z; q += x.y + x.w; }
          sm += __shfl_xor(sm, 1); sm += __shfl_xor(sm, 2); q += __shfl_xor(q, 1); q += __shfl_xor(q, 2);
          const float mean = sm * (1.0f / D); const float var = fmaxf(q * (1.0f / D) - mean * mean, 0.f);
          if (qd == 0) MR[tok] = (f32x2g){mean, 1.0f / sqrtf(var + NORM_EPS)}; }
        if (g != gcur) { gcur = g;
#pragma unroll
            for (int i = 0; i < 8; ++i) { const int idx = tid + 512 * i, t = idx >> 5, s4 = (idx & 31) * 4; const f32x4 w = *(const GAS f32x4*)(w_s + ((size_t)g * 128 + t) * 128 + s4);
                u32x2g o; o.x = cvtpk(s4 + 0 <= t ? w.x : 0.f, s4 + 1 <= t ? w.y : 0.f); o.y = cvtpk(s4 + 2 <= t ? w.z : 0.f, s4 + 3 <= t ? w.w : 0.f);
                *(LAS u32x2g*)(Ws + t * GT_WS + s4 * 2) = o; }
            g0 = *(const GAS f32x4*)(ln_g + g * 256 + ch * 8); g1 = *(const GAS f32x4*)(ln_g + g * 256 + ch * 8 + 4); b0 = *(const GAS f32x4*)(ln_b + g * 256 + ch * 8); b1 = *(const GAS f32x4*)(ln_b + g * 256 + ch * 8 + 4);
#pragma unroll
            for (int tt = 0; tt < 8; ++tt) bb[tt] = b_s[g * 128 + 16 * tt + fr]; }
        __syncthreads();
        { const bool last = (cidx & 15) == 15;
#pragma unroll
          for (int i = 0; i < 8; ++i) { const int row = (tid >> 5) + 16 * i; const v4u x = vraw[i]; const f32x2g mr = MR[row];
              f32x4 a, b; a.x = (bflo(x.x) - mr.x) * mr.y * g0.x + b0.x; a.y = (bfhi(x.x) - mr.x) * mr.y * g0.y + b0.y; a.z = (bflo(x.y) - mr.x) * mr.y * g0.z + b0.z; a.w = (bfhi(x.y) - mr.x) * mr.y * g0.w + b0.w;
              b.x = (bflo(x.z) - mr.x) * mr.y * g1.x + b1.x; b.y = (bfhi(x.z) - mr.x) * mr.y * g1.y + b1.y; b.z = (bflo(x.w) - mr.x) * mr.y * g1.z + b1.z; b.w = (bfhi(x.w) - mr.x) * mr.y * g1.w + b1.w;
              if (last) { float* o = gvp + ((size_t)((cidx >> 4) * 128 + row)) * D + g * 256 + ch * 8; *(GAS f32x4*)o = a; *(GAS f32x4*)(o + 4) = b; }
              v4u w; w.x = cvtpk(a.x, a.y); w.y = cvtpk(a.z, a.w); w.z = cvtpk(b.x, b.y); w.w = cvtpk(b.z, b.w);
              *(LAS v4u*)(Vs + row * GT_VS + ch * 16) = w; } }
        if (hn) ld_v(un);
        __syncthreads();
        f32x4 acc[8][2];
        { bf16x8 vf[2][4];
#pragma unroll
          for (int ct = 0; ct < 2; ++ct)
#pragma unroll
              for (int ks = 0; ks < 4; ++ks) { LAS const unsigned char* p = Vs + (32 * ks + 8 * fq + (fr >> 2)) * GT_VS + (32 * wave + 16 * ct + 4 * (fr & 3)) * 2;
                  vf[ct][ks] = cat8(ldtr(p), ldtr(p + 4 * GT_VS)); }
#pragma unroll
          for (int tt = 0; tt < 8; ++tt) { acc[tt][0] = (f32x4){0.f, 0.f, 0.f, 0.f}; acc[tt][1] = (f32x4){0.f, 0.f, 0.f, 0.f};
#pragma unroll
              for (int ks = 0; ks < 4; ++ks) if (ks <= (tt >> 1)) { const bf16x8 wf = *(LAS const bf16x8*)(Ws + (16 * tt + fr) * GT_WS + (32 * ks + 8 * fq) * 2);
                  acc[tt][0] = __builtin_amdgcn_mfma_f32_16x16x32_bf16(vf[0][ks], wf, acc[tt][0], 0, 0, 0); acc[tt][1] = __builtin_amdgcn_mfma_f32_16x16x32_bf16(vf[1][ks], wf, acc[tt][1], 0, 0, 0); } } }
        __syncthreads();
#pragma unroll
        for (int tt = 0; tt < 8; ++tt) { const int t = 16 * tt + fr;
#pragma unroll
            for (int ct = 0; ct < 2; ++ct) { u32x2g o; o.x = cvtpk(acc[tt][ct][0] + bb[tt], acc[tt][ct][1] + bb[tt]); o.y = cvtpk(acc[tt][ct][2] + bb[tt], acc[tt][ct][3] + bb[tt]);
                *(LAS u32x2g*)(Vs + t * GT_VS + (32 * wave + 16 * ct + 4 * fq) * 2) = o; } }
        if (hn) ld_st(un);
        __syncthreads();
#pragma unroll
        for (int i = 0; i < 8; ++i) { const int row = (tid >> 5) + 16 * i; const v4u sv = *(LAS const v4u*)(Vs + row * GT_VS + ch * 16); const size_t go = (size_t)(t0 + row) * D + g * 256 + ch * 8; const v4u x = uraw[i];
            v4u w; w.x = cvtpk(bflo(x.x) * bflo(sv.x), bfhi(x.x) * bfhi(sv.x)); w.y = cvtpk(bflo(x.y) * bflo(sv.y), bfhi(x.y) * bfhi(sv.y));
            w.z = cvtpk(bflo(x.z) * bflo(sv.z), bfhi(x.z) * bfhi(sv.z)); w.w = cvtpk(bflo(x.w) * bflo(sv.w), bfhi(x.w) * bfhi(sv.w));
            *(GAS v4u*)(GATED + go) = w; }
        if (hn) ld_u(un);
        __syncthreads();
    }
}

constexpr int AT_KS = 144;
constexpr int AT_OFF_K = 0, AT_OFF_V = 256 * AT_KS;
static_assert(AT_OFF_V + 272 * AT_KS <= RING_BYTES, "attention LDS");
template <bool FIRST> __device__ __forceinline__ void attn_unit(LAS unsigned char* lds, int b, int kvh, int qb,     const bf16* QKV, bf16* O, const float* sinks, int tid, int wave, int lane) {
    const int fr = lane & 15, fq = lane >> 4;
    LAS unsigned char* Ks = lds + AT_OFF_K; LAS unsigned char* Vs = lds + AT_OFF_V;
    const size_t tokbase = (size_t)b * SEQ + (size_t)128 * qb;
#pragma unroll
    for (int i = 0; i < 4; ++i) { const int idx = tid + 512 * i, row = idx >> 3, ch = idx & 7; v4u kx = (v4u){0u, 0u, 0u, 0u}, vx = (v4u){0u, 0u, 0u, 0u};
        if (qb > 0 || row >= 128) { const bf16* src = QKV + (tokbase - 128 + row) * NQKV + 4096 + kvh * 64 + ch * 8; kx = *(const GAS v4u*)src; vx = *(const GAS v4u*)(src + 512); }
        *(LAS v4u*)(Ks + row * AT_KS + ch * 16) = kx; *(LAS v4u*)(Vs + row * AT_KS + ch * 16) = vx; }
    if (tid < 128) *(LAS v4u*)(Vs + (256 + (tid >> 3)) * AT_KS + (tid & 7) * 16) = (v4u){0u, 0u, 0u, 0u};
    __syncthreads();
    const int h = kvh * 8 + wave; const float sink = sinks[h];
    for (int qt = 0; qt < 8; ++qt) {
        const bf16* qp = QKV + (tokbase + 16 * qt + fr) * NQKV + h * 64 + 8 * fq;
        const bf16x8 q0 = *(const GAS bf16x8*)qp, q1 = *(const GAS bf16x8*)(qp + 32);
        f32x4 s[9];
        LAS const unsigned char* kbase = Ks + (16 * qt + fr) * AT_KS + fq * 16;
#pragma unroll
        for (int r = 0; r < 9; ++r) { LAS const unsigned char* kp = kbase + r * 16 * AT_KS;
            f32x4 a = (f32x4){0.f, 0.f, 0.f, 0.f};
            a = __builtin_amdgcn_mfma_f32_16x16x32_bf16(*(LAS const bf16x8*)kp, q0, a, 0, 0, 0);
            a = __builtin_amdgcn_mfma_f32_16x16x32_bf16(*(LAS const bf16x8*)(kp + 64), q1, a, 0, 0, 0); s[r] = a; }
        constexpr float SC2 = ATTN_SCALE * 1.44269504089f;
        const float sink2 = sink * 1.44269504089f; float mx = sink2;
#pragma unroll
        for (int r = 0; r < 9; ++r)
#pragma unroll
            for (int i = 0; i < 4; ++i) { const int d = 4 * fq + i - fr;
                bool ok = (r == 0) ? (d >= 0) : ((r == 8) ? (d <= 0) : true);
                if (FIRST) ok = ok && (16 * (qt + r) + 4 * fq + i >= 128);
                const float v = ok ? s[r][i] * SC2 : -INFINITY; s[r][i] = v; mx = fmaxf(mx, v); }
        mx = fmaxf(mx, __shfl_xor(mx, 16)); mx = fmaxf(mx, __shfl_xor(mx, 32));
        float l = 0.f;
#pragma unroll
        for (int r = 0; r < 9; ++r)
#pragma unroll
            for (int i = 0; i < 4; ++i) { const float p = __builtin_amdgcn_exp2f(s[r][i] - mx); s[r][i] = p; l += p; }
        l += __shfl_xor(l, 16); l += __shfl_xor(l, 32); l += __builtin_amdgcn_exp2f(sink2 - mx);
        const float inv = 1.0f / l;
        f32x4 o[4];
#pragma unroll
        for (int dt = 0; dt < 4; ++dt) o[dt] = (f32x4){0.f, 0.f, 0.f, 0.f};
        LAS const unsigned char* vbase = Vs + (16 * qt + 4 * fq + (fr >> 2)) * AT_KS + (4 * (fr & 3)) * 2;
#pragma unroll
        for (int ks = 0; ks < 5; ++ks) { v4u pw; pw.x = cvtpk(s[2 * ks][0], s[2 * ks][1]); pw.y = cvtpk(s[2 * ks][2], s[2 * ks][3]);
            if (ks < 4) { pw.z = cvtpk(s[2 * ks + 1][0], s[2 * ks + 1][1]); pw.w = cvtpk(s[2 * ks + 1][2], s[2 * ks + 1][3]); } else { pw.z = 0u; pw.w = 0u; }
            const bf16x8 pb = __builtin_bit_cast(bf16x8, pw);
#pragma unroll
            for (int dt = 0; dt < 4; ++dt) { LAS const unsigned char* vp = vbase + ks * 32 * AT_KS + dt * 32;
                o[dt] = __builtin_amdgcn_mfma_f32_16x16x32_bf16(cat8(ldtr(vp), ldtr(vp + 16 * AT_KS)), pb, o[dt], 0, 0, 0); } }
        bf16* op = O + (tokbase + 16 * qt + fr) * D + h * 64 + 4 * fq;
#pragma unroll
        for (int dt = 0; dt < 4; ++dt) { u32x2g w; w.x = cvtpk(o[dt][0] * inv, o[dt][1] * inv); w.y = cvtpk(o[dt][2] * inv, o[dt][3] * inv); *(GAS u32x2g*)(op + 16 * dt) = w; }
    }
    __syncthreads();
}

__device__ __forceinline__ void attn_sample_task(int b, int h, const float* qkvs, const float* ck, const float* cv, const float* sinks, bf16* os, int lane) {
    const int kvh = h >> 3;
    const float q = qkvs[(size_t)b * NQKV + h * 64 + lane] * ATTN_SCALE;
    const float* kp = ck + ((size_t)b * 128 * 8 + kvh) * 64 + lane; const float* vp = cv + ((size_t)b * 128 * 8 + kvh) * 64 + lane;
    const float knew = qkvs[(size_t)b * NQKV + 4096 + kvh * 64 + lane], vnew = qkvs[(size_t)b * NQKV + 4608 + kvh * 64 + lane];
    float s[2] = {0.f, 0.f};
#pragma unroll
    for (int hb = 0; hb < 2; ++hb) { float kk[64];
#pragma unroll
        for (int j = 0; j < 64; ++j) kk[j] = kp[(size_t)(64 * hb + j) * 512];
#pragma unroll
        for (int j = 0; j < 64; ++j) { const float sj = wave_sum(q * kk[j]); s[hb] = (lane == j) ? sj : s[hb]; }
        asm volatile("" ::: "memory"); }
    const float snew = wave_sum(q * knew), sink = sinks[h];
    const float m = fmaxf(fmaxf(wave_max(fmaxf(s[0], s[1])), snew), sink);
    const float p0 = __expf(s[0] - m), p1 = __expf(s[1] - m), pnew = __expf(snew - m);
    const float l = wave_sum(p0 + p1) + pnew + __expf(sink - m);
    float o = pnew * vnew;
#pragma unroll
    for (int hb = 0; hb < 2; ++hb) { float vv[64]; const float ph = hb ? p1 : p0;
#pragma unroll
        for (int j = 0; j < 64; ++j) vv[j] = vp[(size_t)(64 * hb + j) * 512];
#pragma unroll
        for (int j = 0; j < 64; ++j) o += __int_as_float(__builtin_amdgcn_readlane(__float_as_int(ph), j)) * vv[j];
        asm volatile("" ::: "memory"); }
    os[(size_t)b * D + h * 64 + lane] = (bf16)f2bf(o / l);
}


struct Args { const float* in[N_IN]; float* out; unsigned char* ws; };
static_assert(sizeof(Args) == (N_IN + 2) * 8, "Args has no padding");

#ifndef PHMASK
#define PHMASK 0xFFFFFFFFu
#endif
#define PH(k) if constexpr (((PHMASK) >> (k)) & 1u)
#ifndef REPMASK
#define REPMASK 0u
#endif
#ifndef NREP_GEMM
#define NREP_GEMM 1
#endif
#ifndef SKQ_UP
#define SKQ_UP 8
#endif
#ifndef PHREP5
#define PHREP5 1
#endif
#ifndef PHRMASK
#define PHRMASK 0u
#endif
#ifndef PHRN
#define PHRN 4
#endif
#define PHR(k) ((((PHRMASK) >> (k)) & 1u) ? PHRN : 1)
#ifndef NREP_SK
#define NREP_SK 1
#endif
#define NREP(k) ((((REPMASK) >> (k)) & 1u) ? 2 : 1)
#ifndef GREPMASK
#define GREPMASK 0u
#endif
#define NREPG(k) ((((GREPMASK) >> (k)) & 1u) ? 2 : 1)
#define CAS __attribute__((address_space(4)))
#define DEFPTRS() const CAS Args* A_ = kargs; asm volatile("" : "+s"(A_)); int tid_ = tid0; asm volatile("" : "+v"(tid_)); const int tid = tid_, lane = tid & 63, wave = __builtin_amdgcn_readfirstlane(tid >> 6), gw = vcu * NWAVES + wave, gt = vcu * NWAVES * 64 + tid; (void)gw; (void)gt; (void)lane; unsigned char* ws = A_->ws; float* out = A_->out; gu32* ctl = (gu32*)(ws + WS_CTL); const float* xp = A_->in[I_XP]; const float* xs = A_->in[I_XS]; const float* cache_k = A_->in[I_CK]; const float* cache_v = A_->in[I_CV]; const float* state_conv = A_->in[I_SC]; const float* nm_pre = A_->in[I_NMPRE]; const float* nm_post = A_->in[I_NMPOST]; const float* nf_pre = A_->in[I_NFPRE]; const float* nf_post = A_->in[I_NFPOST]; bf16* WIN = (bf16*)(ws + WS_WIN); bf16* WOUT = (bf16*)(ws + WS_WOUT); bf16* WQKV = (bf16*)(ws + WS_WQKV); bf16* WO = (bf16*)(ws + WS_WO); bf16* WUP = (bf16*)(ws + WS_WUP); bf16* WDN = (bf16*)(ws + WS_WDN); bf16* HN = (bf16*)(ws + WS_HN); bf16* U = (bf16*)(ws + WS_U); bf16* V = (bf16*)(ws + WS_V); float* VSTAT = (float*)(ws + WS_VSTAT); bf16* GATED = (bf16*)(ws + WS_GATED); bf16* Y = (bf16*)(ws + WS_Y); bf16* X = (bf16*)(ws + WS_X); float* R2 = (float*)(ws + WS_R2); float* RQ = (float*)(ws + WS_RQ); float* SW = (float*)(ws + WS_SW); unsigned char* XQ = ws + WS_XQ; unsigned char* WQUP = ws + WS_WQUP; unsigned char* WQIN = ws + WS_WQIN; unsigned char* WQQKV = ws + WS_WQQKV; float* CMAX = (float*)(ctl + CW_CMAX); float* HALOB = (float*)(ws + WS_HALOB); float* HALOT = (float*)(ws + WS_HALOT); bf16* ACT = (bf16*)(ws + WS_ACT); bf16* QKV = (bf16*)(ws + WS_QKV); unsigned char* sm = ws + WS_SMP; bf16* HS = (bf16*)(sm + SM_HS); float* ZS = (float*)(sm + SM_ZS); bf16* GS = (bf16*)(sm + SM_GS); float* YS = (float*)(sm + SM_YS); float* XS = (float*)(sm + SM_XS); float* HHS = (float*)(sm + SM_HHS); bf16* ACTS = (bf16*)(sm + SM_ACTS); float* QKVS = (float*)(sm + SM_QKVS); unsigned char* ACTQ = ws + WS_ACTQ; unsigned char* WQDN = ws + WS_WQDN; float* SA = (float*)(ws + WS_SA); unsigned char* HSQ = sm + SM_HSQ; unsigned char* HHSQ_ = sm + SM_HHS; float* SAS = (float*)(sm + SM_SAS); float* HSS = (float*)(sm + SM_HSS);
#define P0_DEFS() \
        constexpr int I_A = 64 * 128, I_B = 64 * 64, I_C = 64 * 80, I_U = 64 * 344, I_D = 172 * 64; \
        constexpr int NITEMS = I_A + 2 * I_B + I_C + 2 * I_D, P0_LATE = 0; (void)P0_LATE; (void)I_U; \
        auto seg = [&](int it) { P0Seg sg; int r = it; sg.up = false; sg.had = false; sg.g = nullptr; sg.cmax = nullptr; \
            if (r < I_A) { sg.W = A_->in[I_WIN]; sg.WT = WIN; sg.g = nm_pre; sg.cmax = CMAX + 2 * DFF2; sg.K = D; sg.N = DZ; sg.item = r; return sg; } r -= I_A; \
            if (r < I_B) { sg.W = A_->in[I_WOUT]; sg.WT = WOUT; sg.K = D; sg.N = D; sg.item = r; return sg; } r -= I_B; \
            if (r < I_C) { sg.W = A_->in[I_WQKV]; sg.WT = WQKV; sg.g = nm_pre + D; sg.cmax = CMAX + 2 * DFF2 + DZ; sg.K = D; sg.N = NQKV; sg.item = r; return sg; } r -= I_C; \
            if (r < I_B) { sg.W = A_->in[I_WO]; sg.WT = WO; sg.K = D; sg.N = D; sg.item = r; return sg; } r -= I_B; \
            { const int l = r >= I_D; sg.W = A_->in[I_WDN] + (size_t)l * DFF * D; sg.WT = WDN + (size_t)l * DFF * D; sg.had = true; sg.cmax = CMAX + QC_DN + l * D; sg.K = DFF; sg.N = D; sg.item = r - l * I_D; return sg; } }; \
        auto convert = [&](int it0, int it_end, int step) {     \
            if (it0 < it_end) { f32x4 va[16], vb[16]; P0Seg sa = seg(it0), sb; p0_load(sa, lane, va); \
                for (int it = it0; it < it_end; it += 2 * step) { \
                    const bool hb = it + step < it_end; if (hb) { sb = seg(it + step); p0_load(sb, lane, vb); } \
                    p0_store(sa, lane, va, T); \
                    const bool ha = it + 2 * step < it_end; if (ha) { sa = seg(it + 2 * step); p0_load(sa, lane, va); } \
                    if (hb) p0_store(sb, lane, vb, T); } } }; \
        auto grab = [&]() { unsigned v = 0u; if (lane == 0) v = xb_add((unsigned*)(ws + WS_CTL) + CW_ITEM, 1u); return (int)__builtin_amdgcn_readfirstlane(v); };     \
        auto convert_dyn = [&]() {     \
            f32x4 va[16], vb[16]; P0Seg sa, sb; int ia = grab(); if (ia < NITEMS) { sa = seg(ia); p0_load(sa, lane, va); } \
            while (ia < NITEMS) { const int ib = grab(); const bool hb = ib < NITEMS; if (hb) { sb = seg(ib); p0_load(sb, lane, vb); } \
                p0_store(sa, lane, va, T); \
                ia = hb ? grab() : NITEMS; if (ia < NITEMS) { sa = seg(ia); p0_load(sa, lane, va); } \
                if (hb) p0_store(sb, lane, vb, T); } };
__global__ void __launch_bounds__(NWAVES * 64, 2) fwd(Args args) {
    extern __shared__ __attribute__((aligned(16))) unsigned char lds_raw[];
    LAS unsigned char* lds = (LAS unsigned char*)lds_raw;
    volatile LAS unsigned* MISC = (volatile LAS unsigned*)(lds + MISC_OFF);
    const int tid0 = threadIdx.x;
    const int G = gridDim.x, bx = blockIdx.x;
    const int vcu = (G % 8 == 0) ? (bx % 8) * (G / 8) + bx / 8 : bx;
    const int NGW = G * NWAVES, NGT = G * NWAVES * 64;
    const CAS Args* kargs = (const CAS Args*)__builtin_amdgcn_kernarg_segment_ptr();
    for (int u = tid0; u < (LDS_BYTES - LDSCTL_OFF) / 4; u += NWAVES * 64) ((LAS unsigned*)(lds + LDSCTL_OFF))[u] = 0u;
    __syncthreads();
    XcdBarrier bar = xcd_barrier_post((unsigned*)(kargs->ws + WS_CTL) + CW_BAR, MISC + 8);
#define GRID_BAR() do { XcdBarrier b_ = bar; b_.bar = (unsigned*)(kargs->ws + WS_CTL) + CW_BAR; asm volatile("" : "+s"(b_.x)); xcd_barrier(b_); } while (0)
#define PROMPT_GEMM(EpiT, Eobj, Aptr, Bptr, Nn, Kk) do { pg8::Gemm g_{(const pg8::bf16_t*)(Aptr), (const pg8::bf16_t*)(Bptr), MP, (Nn), (Kk)}; pg8::StaticOrder S_; S_.init(MP, (Nn), G, bx); \
        for (int rg_ = 0; rg_ < NREP_GEMM * NRG_; ++rg_) pg8::gemm_phase<EpiT, pg8::StaticOrder, true, true>(lds + RING_OFF, g_, S_, Eobj); } while (0)

    PH(0) for (int rep_ = 0; rep_ < NREP(0); ++rep_) { DEFPTRS(); if (rep_) __syncthreads();
        LAS unsigned char* T = lds + RING_OFF + wave * 9216;
        P0_DEFS();
        for (int s = vcu, par = 0; s < 2 * (DFF2 / 32); s += G, par ^= 1) { const int l = s >= DFF2 / 32;
            p0_strip_up(lds, A_->in[I_WUP] + (size_t)l * D * DFF2, nf_pre + l * D, WQUP + (size_t)l * D * DFF2, SW + l * DFF2, s - l * (DFF2 / 32), par, lane, wave); }
        __syncthreads();
        { constexpr int NSTRIP = 2 * (DFF2 / 32); const int rem_ = NSTRIP % G, nlight = rem_ ? G - rem_ : 0, xtra = 3 * nlight * NWAVES;
          convert(gw, NITEMS - xtra, NGW); if (nlight && vcu >= rem_) convert(NITEMS - xtra + (vcu - rem_) * NWAVES + wave, NITEMS, nlight * NWAVES); (void)convert_dyn; }
        for (int r = gw; r < MP + MS; r += NGW) {
            if (r < MP) { if (EPI_IN_I8) first_row<false>(xp + (size_t)r * D, HN + (size_t)r * D, R2 + r, lane, XQ + (size_t)r * D, RQ + r); else first_row<false>(xp + (size_t)r * D, HN + (size_t)r * D, R2 + r, lane); }
            else first_row<true>(xs + (size_t)(r - MP) * D, HS + (size_t)(r - MP) * D, nullptr, lane);
        }
    }
    GRID_BAR();

    PH(17) _Pragma("unroll") for (int pr_ = 0; pr_ < PHR(17); ++pr_) { if (pr_) GRID_BAR(); DEFPTRS(); constexpr int NQ_ = 2 * DFF2 + (EPI_IN_I8 ? DZ : 0) + (EPI_QKV_I8 ? NQKV : 0);
        for (int idx = gt + 2 * DFF2 * (D / 16); idx < NQ_ * (D / 16); idx += NGT) { int row = idx >> 8;     const int ch = idx & 255; if (!EPI_IN_I8 && row >= 2 * DFF2) row += DZ; const float m = CMAX[row]; const float inv = m > 0.f ? 127.0f / m : 0.f;
            const bf16* src; unsigned char* dst;
            if (row < 2 * DFF2) { src = WUP + (size_t)row * D; dst = WQUP + (size_t)row * D; } else if (row < 2 * DFF2 + DZ) { src = WIN + (size_t)(row - 2 * DFF2) * D; dst = WQIN + (size_t)(row - 2 * DFF2) * D; }
            else { src = WQKV + (size_t)(row - 2 * DFF2 - DZ) * D; dst = WQQKV + (size_t)(row - 2 * DFF2 - DZ) * D; }
            const v4u x = *(const GAS v4u*)(src + ch * 16), y = *(const GAS v4u*)(src + ch * 16 + 8); v4u q;
            q.x = q8x4(bflo(x.x), bfhi(x.x), bflo(x.y), bfhi(x.y), inv); q.y = q8x4(bflo(x.z), bfhi(x.z), bflo(x.w), bfhi(x.w), inv); q.z = q8x4(bflo(y.x), bfhi(y.x), bflo(y.y), bfhi(y.y), inv); q.w = q8x4(bflo(y.z), bfhi(y.z), bflo(y.w), bfhi(y.w), inv);
            *(GAS v4u*)(dst + ch * 16) = q; if (ch == 0) SW[row] = m * (1.0f / 127.0f); }
        for (int idx0 = gt; idx0 < 2 * D * (DFF / 16); idx0 += 4 * NGT) {
            v4u xx[4], yy[4]; float mm[4];
#pragma unroll
            for (int u = 0; u < 4; ++u) { const int idx = idx0 + u * NGT; if (idx < 2 * D * (DFF / 16)) { const int row = idx / (DFF / 16), ch = idx - row * (DFF / 16); const bf16* src = WDN + (size_t)row * DFF + ch * 16;
                mm[u] = CMAX[QC_DN + row]; xx[u] = *(const GAS v4u*)src; yy[u] = *(const GAS v4u*)(src + 8); } }
#pragma unroll
            for (int u = 0; u < 4; ++u) { const int idx = idx0 + u * NGT; if (idx < 2 * D * (DFF / 16)) { const int row = idx / (DFF / 16), ch = idx - row * (DFF / 16); const float m = mm[u]; const float inv = m > 0.f ? 127.0f / m : 0.f; const v4u x = xx[u], y = yy[u]; v4u q;
                q.x = q8x4(bflo(x.x), bfhi(x.x), bflo(x.y), bfhi(x.y), inv); q.y = q8x4(bflo(x.z), bfhi(x.z), bflo(x.w), bfhi(x.w), inv); q.z = q8x4(bflo(y.x), bfhi(y.x), bflo(y.y), bfhi(y.y), inv); q.w = q8x4(bflo(y.z), bfhi(y.z), bflo(y.w), bfhi(y.w), inv);
                *(GAS v4u*)(WQDN + (size_t)row * DFF + ch * 16) = q; if (ch == 0) SW[QC_DN + row] = m * (1.0f / 127.0f); } } }
    }
    GRID_BAR();

    PH(1) { DEFPTRS(); constexpr int NRG_ = NREPG(1); pg8::EpiGeluUV E{U, V, VSTAT, EPI_IN_I8 ? RQ : R2, SW + 2 * DFF2}; if (EPI_IN_I8) PROMPT_GEMM(pg8::EpiGeluUV, E, XQ, WQIN, DZ, D / 2); else PROMPT_GEMM(pg8::EpiGeluUV, E, HN, WIN, DZ, D);
      for (int rs_ = 0; rs_ < NREP_SK; ++rs_) skinny_plain<32, 1>(lds, HS, WIN, DZ, D, ZS, DZ, nullptr, bx, DZ / 32, G, tid, wave, lane); }
    GRID_BAR();

    PH(2) { DEFPTRS();
        const float* ln_g = A_->in[I_LNG]; const float* ln_b = A_->in[I_LNB]; const float* w_s = A_->in[I_WS]; const float* b_s = A_->in[I_BS];
        for (int rp_ = 0; rp_ < NREP(2); ++rp_) gate_units(lds, bx, 64 * 16, G, U, V, VSTAT, ln_g, ln_b, w_s, b_s, GATED, out + O_GVP, tid, wave, lane);
        if (gw < MS) {
            const int b = gw; const GAS f32x4* vr = (const GAS f32x4*)(ZS + (size_t)b * DZ + D) + lane; const GAS f32x4* ur = (const GAS f32x4*)(ZS + (size_t)b * DZ) + lane;
            f32x4 v[16]; float s = 0.f;
#pragma unroll
            for (int j = 0; j < 16; ++j) { v[j] = vr[64 * j]; s += (v[j].x + v[j].y) + (v[j].z + v[j].w); }
            const float mean = wave_sum(s) * (1.0f / D); float q = 0.f;
#pragma unroll
            for (int j = 0; j < 16; ++j) { v[j] = v[j] - mean; q += (v[j].x * v[j].x + v[j].y * v[j].y) + (v[j].z * v[j].z + v[j].w * v[j].w); }
            const float rstd = 1.0f / sqrtf(wave_sum(q) * (1.0f / D) + NORM_EPS);
            GAS f32x4* go = (GAS f32x4*)(out + O_GVS + (size_t)b * D) + lane; GAS u32x2g* gs = (GAS u32x2g*)(GS + (size_t)b * D) + lane;
#pragma unroll
            for (int j = 0; j < 16; ++j) { const f32x4 gg = ((const GAS f32x4*)ln_g)[lane + 64 * j], bb = ((const GAS f32x4*)ln_b)[lane + 64 * j]; const f32x4 vn = v[j] * rstd * gg + bb; go[64 * j] = vn;
                const float w00 = w_s[(size_t)j * 128 * 128], b0 = b_s[j * 128]; const f32x4 uu = ur[64 * j]; const f32x4 gt4 = uu * (vn * w00 + b0);
                u32x2g w; w.x = cvtpk(gt4.x, gt4.y); w.y = cvtpk(gt4.z, gt4.w); gs[64 * j] = w; }
        }
    }
    GRID_BAR();

    PH(3) { DEFPTRS(); constexpr int NRG_ = NREPG(3); pg8::EpiBf16B E{Y, D, nullptr}; PROMPT_GEMM(pg8::EpiBf16B, E, GATED, WOUT, D, D);
      for (int rs_ = 0; rs_ < NREP_SK; ++rs_) skinny_plain<16, 0>(lds, GS, WOUT, D, D, YS, D, nullptr, bx, D / 16, G, tid, wave, lane); }
    GRID_BAR();

    PH(4) _Pragma("unroll") for (int pr_ = 0; pr_ < PHR(4); ++pr_) { if (pr_) GRID_BAR(); DEFPTRS();
        for (int r = gw; r < MP; r += 2 * NGW) { const int rb = (r + NGW < MP) ? r + NGW : r; const size_t oa = (size_t)r * D, ob = (size_t)rb * D;
            const int ca_ = ((r & (SEQ - 1)) >= SEQ - 2) ? 32 + 2 * (r / SEQ) + (r & 1) : -1, cb_ = ((rb & (SEQ - 1)) >= SEQ - 2) ? 32 + 2 * (rb / SEQ) + (rb & 1) : -1;
            unsigned char* cqa = ca_ >= 0 ? HSQ + (size_t)ca_ * D : (unsigned char*)nullptr; unsigned char* cqb = cb_ >= 0 ? HSQ + (size_t)cb_ * D : (unsigned char*)nullptr; float* csa = ca_ >= 0 ? HSS + ca_ : (float*)nullptr; float* csb = cb_ >= 0 ? HSS + cb_ : (float*)nullptr;
            resid_norm_row2<bf16, true>(Y + oa, Y + ob, HN + oa, HN + ob, X + oa, X + ob, nm_post, R2 + r, R2 + rb, lane, XQ + oa, XQ + ob, RQ + r, RQ + rb, cqa, cqb, csa, csb); }
        if (gw < MS) { const size_t o = (size_t)gw * D; resid_norm_row(YS + o, xs + o, nm_post, XS + o, (float*)nullptr, HS + o, lane, HSQ + o, HSS + gw); }
    }
    GRID_BAR();

#define FFN_PHASES(L) \
    PH(5 + 8 * (L)) _Pragma("unroll") for (int pr_ = 0; pr_ < PHREP5; ++pr_) { if (pr_) GRID_BAR(); DEFPTRS(); constexpr int NRG_ = NREPG(5 + 8 * (L)); pg8::EpiUpConv E{ACT, HALOB, HALOT, A_->in[I_CW] + (size_t)(L) * 3 * DFF2, A_->in[I_CB] + (size_t)(L) * DFF2, (LAS float*)(lds + XH_OFF), RQ, SW + (L) * DFF2}; \
      PROMPT_GEMM(pg8::EpiUpConv, E, XQ, WQUP + (size_t)(L) * D * DFF2, DFF2, D / 2);     \
      for (int rs_ = 0; rs_ < NREP_SK; ++rs_) { const float* cw = A_->in[I_CW] + (size_t)(L) * 3 * DFF2; const float* cb = A_->in[I_CB] + (size_t)(L) * DFF2; \
        const float* sc = state_conv + (size_t)(L) * MS * 2 * DFF2; float* cvs = out + O_CVS + (size_t)(L) * MS * 2 * DFF2; \
        auto rowof = [](int tile, int c) { return 256 * (tile >> 3) + 16 * (tile & 7) + 128 * c; };     \
        float* cvp = out + O_CVP + (size_t)(L) * NBATCH * 2 * DFF2; \
        const float* swl = SW + (L) * DFF2;     \
        auto epi = [=](int tile, int t, LAS const float* sums) { if (t >= 512 + 128) return; const int b = t >> 4, j = 128 * (tile >> 3) + 16 * (tile & 7) + (t & 15), rg_ = 256 * (tile >> 3) + 16 * (tile & 7) + (t & 15); \
            const float hsr = HSS[b], hg = sums[b * 32 + (t & 15)] * swl[rg_] * hsr, hv = sums[b * 32 + 16 + (t & 15)] * swl[rg_ + 128] * hsr; \
            if (t >= 512) { cvp[(size_t)(b - 32) * DFF2 + j] = hg; cvp[(size_t)(b - 32) * DFF2 + DFF + j] = hv; return; }     \
            const float s0g = sc[((size_t)b * 2 + 0) * DFF2 + j], s1g = sc[((size_t)b * 2 + 1) * DFF2 + j], s0v = sc[((size_t)b * 2 + 0) * DFF2 + DFF + j], s1v = sc[((size_t)b * 2 + 1) * DFF2 + DFF + j]; \
            const float cg = cb[j] + cw[j] * s0g + cw[DFF2 + j] * s1g + cw[2 * DFF2 + j] * hg; \
            const float cv = cb[DFF + j] + cw[DFF + j] * s0v + cw[DFF2 + DFF + j] * s1v + cw[2 * DFF2 + DFF + j] * hv; \
            ACTS[(size_t)b * DFF + j] = (bf16)f2bf(silu_mul(cg, cv)); \
            cvs[((size_t)b * 2 + 0) * DFF2 + j] = s1g; cvs[((size_t)b * 2 + 0) * DFF2 + DFF + j] = s1v; cvs[((size_t)b * 2 + 1) * DFF2 + j] = hg; cvs[((size_t)b * 2 + 1) * DFF2 + DFF + j] = hv; }; \
        int tb_, te_, ts_; skinny_assign(DFF / 16, (MP / 256) * (DFF2 / 256), SKQ_UP, bx, G, tb_, te_, ts_); \
        skinny_i8_resident<32, 3>(lds, HSQ, WQUP + (size_t)(L) * D * DFF2, tb_, te_, ts_, rowof, epi, tid, wave, lane); } } \
    GRID_BAR(); \
    PH(6 + 8 * (L)) _Pragma("unroll") for (int pr_ = 0; pr_ < PHR(6 + 8 * (L)); ++pr_) { if (pr_) GRID_BAR(); DEFPTRS(); const float* cw = A_->in[I_CW] + (size_t)(L) * 3 * DFF2; const float* cb = A_->in[I_CB] + (size_t)(L) * DFF2; \
      for (int idx = gt; idx < 28 * (DFF / 4); idx += NGT) { const int pq = idx / (DFF / 4), j = 4 * (idx - pq * (DFF / 4)), pm = pq + 1 + pq / 7;     \
          const int cg_ = 256 * (j >> 7) + (j & 127); const float* hb = HALOB + (size_t)(pm - 1) * 2 * DFF2 + cg_; const float* ht = HALOT + (size_t)pm * 2 * DFF2 + cg_; \
          const f32x4 g254 = *(const GAS f32x4*)hb, g255 = *(const GAS f32x4*)(hb + DFF2), g0 = *(const GAS f32x4*)ht, g1 = *(const GAS f32x4*)(ht + DFF2); \
          const f32x4 v254 = *(const GAS f32x4*)(hb + 128), v255 = *(const GAS f32x4*)(hb + DFF2 + 128), v0 = *(const GAS f32x4*)(ht + 128), v1 = *(const GAS f32x4*)(ht + DFF2 + 128); \
          const f32x4 wg0 = *(const GAS f32x4*)(cw + j), wg1 = *(const GAS f32x4*)(cw + DFF2 + j), wg2 = *(const GAS f32x4*)(cw + 2 * DFF2 + j), wv0 = *(const GAS f32x4*)(cw + DFF + j), wv1 = *(const GAS f32x4*)(cw + DFF2 + DFF + j), wv2 = *(const GAS f32x4*)(cw + 2 * DFF2 + DFF + j); \
          const f32x4 bg = *(const GAS f32x4*)(cb + j), bv = *(const GAS f32x4*)(cb + DFF + j); \
          const f32x4 cg0 = bg + wg0 * g254 + wg1 * g255 + wg2 * g0, cv0 = bv + wv0 * v254 + wv1 * v255 + wv2 * v0, cg1 = bg + wg0 * g255 + wg1 * g0 + wg2 * g1, cv1 = bv + wv0 * v255 + wv1 * v0 + wv2 * v1; \
          u32x2g o0, o1; o0.x = cvtpk(silu_mul(cg0.x, cv0.x), silu_mul(cg0.y, cv0.y)); o0.y = cvtpk(silu_mul(cg0.z, cv0.z), silu_mul(cg0.w, cv0.w)); o1.x = cvtpk(silu_mul(cg1.x, cv1.x), silu_mul(cg1.y, cv1.y)); o1.y = cvtpk(silu_mul(cg1.z, cv1.z), silu_mul(cg1.w, cv1.w)); \
          *(GAS u32x2g*)(ACT + (size_t)(pm * 256) * DFF + j) = o0; *(GAS u32x2g*)(ACT + (size_t)(pm * 256 + 1) * DFF + j) = o1; } \
    } \
    GRID_BAR(); \
    PH(18 + (L)) _Pragma("unroll") for (int pr_ = 0; pr_ < PHR(18 + (L)); ++pr_) { if (pr_) GRID_BAR(); DEFPTRS();     \
      act_rot_rows(ACT, ACTQ, SA, gw, MP, NGW, lane); \
      if (gw < MS) act_rot_row<true>(ACTS + (size_t)gw * DFF, HHSQ_ + (size_t)gw * DFF, SAS + gw, (bf16*)nullptr, lane);     \
    } \
    GRID_BAR(); \
    PH(7 + 8 * (L)) { DEFPTRS(); constexpr int NRG_ = NREPG(7 + 8 * (L)); pg8::EpiBf16BQ E{Y, D, SA, SW + QC_DN + (L) * D}; PROMPT_GEMM(pg8::EpiBf16BQ, E, ACTQ, WQDN + (size_t)(L) * DFF * D, D, DFF / 2); \
      for (int rs_ = 0; rs_ < NREP_SK; ++rs_) { const float* swd = SW + QC_DN + (L) * D; auto rowof = [](int tile, int c) { return tile * 16 + 16 * c; }; \
        auto epi = [=](int tile, int t, LAS const float* sums) { const int row = t >> 4, col = tile * 16 + (t & 15); YS[(size_t)row * D + col] = sums[t] * SAS[row] * swd[col]; }; \
        skinny_i8<16, 2>(lds, HHSQ_, WQDN + (size_t)(L) * DFF * D, DFF, bx, D / 16, G, rowof, epi, tid, wave, lane); } } \
    GRID_BAR();

    FFN_PHASES(0)

    PH(8) { DEFPTRS();
        for (int r = gw; r < MP; r += 2 * NGW) { const int rb = (EPI_QKV_I8 && r + NGW >= MP) ? r : r + NGW; const size_t oa = (size_t)r * D, ob = (size_t)rb * D;
            if (EPI_QKV_I8) resid_norm_row2<bf16, true>(Y + oa, Y + ob, X + oa, X + ob, X + oa, X + ob, nf_post, R2 + r, R2 + rb, lane, XQ + oa, XQ + ob, RQ + r, RQ + rb);
            else if (rb < MP) resid_norm_row2(Y + oa, Y + ob, X + oa, X + ob, X + oa, X + ob, nf_post, R2 + r, R2 + rb, lane);
            else resid_norm_row(Y + oa, X + oa, nf_post, X + oa, R2 + r, (bf16*)nullptr, lane); }
        if (gw < MS) { const size_t o = (size_t)gw * D; resid_norm_row(YS + o, XS + o, nf_post, XS + o, (float*)nullptr, HS + o, lane); }
    }
    GRID_BAR();

    PH(9) { DEFPTRS(); constexpr int NRG_ = NREPG(9); pg8::EpiQkv E{QKV, A_->in[I_BQKV], out + O_WKP, out + O_WVP, EPI_QKV_I8 ? RQ : R2, SW + 2 * DFF2 + DZ}; if (EPI_QKV_I8) PROMPT_GEMM(pg8::EpiQkv, E, XQ, WQQKV, NQKV, D / 2); else PROMPT_GEMM(pg8::EpiQkv, E, X, WQKV, NQKV, D);
      for (int rs_ = 0; rs_ < NREP_SK; ++rs_) { int tb_, te_, ts_; skinny_assign(NQKV / 32, (MP / 256) * (NQKV / 256), 2, bx, G, tb_, te_, ts_); skinny_plain<32, 0>(lds, HS, WQKV, NQKV, D, QKVS, NQKV, A_->in[I_BQKV], tb_, te_, ts_, tid, wave, lane); }
    }
    GRID_BAR();

    PH(10) { DEFPTRS();
        const float* sinks = A_->in[I_SINK];
        for (int rp_ = 0; rp_ < NREP(10); ++rp_) for (int u = bx; u < NBATCH * 8 * 16; u += G) { if ((u & 15) == 0) attn_unit<true>(lds, u >> 7, (u >> 4) & 7, u & 15, QKV, GATED, sinks, tid, wave, lane); else attn_unit<false>(lds, u >> 7, (u >> 4) & 7, u & 15, QKV, GATED, sinks, tid, wave, lane); }
        for (int t = gw; t < MS * 64; t += NGW) attn_sample_task(t >> 6, t & 63, QKVS, cache_k, cache_v, sinks, GS, lane);
        for (int idx0 = gt; idx0 < MS * 128 * 128; idx0 += 4 * NGT) { f32x4 kk[4], vv[4];
#pragma unroll
            for (int u = 0; u < 4; ++u) { const int idx = idx0 + u * NGT; if (idx < MS * 128 * 128) { const int b = idx >> 14, r = (idx >> 7) & 127, c4 = (idx & 127) * 4;
                if (r < 127) { kk[u] = *(const GAS f32x4*)(cache_k + ((size_t)b * 128 + r + 1) * 512 + c4); vv[u] = *(const GAS f32x4*)(cache_v + ((size_t)b * 128 + r + 1) * 512 + c4); }
                else { kk[u] = *(const GAS f32x4*)(QKVS + (size_t)b * NQKV + 4096 + c4); vv[u] = *(const GAS f32x4*)(QKVS + (size_t)b * NQKV + 4608 + c4); } } }
#pragma unroll
            for (int u = 0; u < 4; ++u) { const int idx = idx0 + u * NGT; if (idx < MS * 128 * 128) { const int b = idx >> 14, r = (idx >> 7) & 127, c4 = (idx & 127) * 4;
                *(GAS f32x4*)(out + O_WKS + ((size_t)b * 128 + r) * 512 + c4) = kk[u]; *(GAS f32x4*)(out + O_WVS + ((size_t)b * 128 + r) * 512 + c4) = vv[u]; } } }
    }
    GRID_BAR();

    PH(11) { DEFPTRS(); constexpr int NRG_ = NREPG(11); pg8::EpiBf16B E{Y, D, A_->in[I_BO]}; PROMPT_GEMM(pg8::EpiBf16B, E, GATED, WO, D, D);
      for (int rs_ = 0; rs_ < NREP_SK; ++rs_) skinny_plain<16, 0>(lds, GS, WO, D, D, YS, D, A_->in[I_BO], bx, D / 16, G, tid, wave, lane); }
    GRID_BAR();

    PH(12) { DEFPTRS();
        for (int r = gw; r < MP; r += 2 * NGW) { const int rb = (r + NGW < MP) ? r + NGW : r; const size_t oa = (size_t)r * D, ob = (size_t)rb * D;
            const int ca_ = ((r & (SEQ - 1)) >= SEQ - 2) ? 32 + 2 * (r / SEQ) + (r & 1) : -1, cb_ = ((rb & (SEQ - 1)) >= SEQ - 2) ? 32 + 2 * (rb / SEQ) + (rb & 1) : -1;
            unsigned char* cqa = ca_ >= 0 ? HSQ + (size_t)ca_ * D : (unsigned char*)nullptr; unsigned char* cqb = cb_ >= 0 ? HSQ + (size_t)cb_ * D : (unsigned char*)nullptr; float* csa = ca_ >= 0 ? HSS + ca_ : (float*)nullptr; float* csb = cb_ >= 0 ? HSS + cb_ : (float*)nullptr;
            resid_norm_row2<bf16, true>(Y + oa, Y + ob, X + oa, X + ob, X + oa, X + ob, nm_post + D, R2 + r, R2 + rb, lane, XQ + oa, XQ + ob, RQ + r, RQ + rb, cqa, cqb, csa, csb); }
        if (gw < MS) { const size_t o = (size_t)gw * D; resid_norm_row(YS + o, XS + o, nm_post + D, XS + o, (float*)nullptr, HS + o, lane, HSQ + o, HSS + gw); }
    }
    GRID_BAR();

    FFN_PHASES(1)

    PH(16) _Pragma("unroll") for (int pr_ = 0; pr_ < PHR(16); ++pr_) { if (pr_) GRID_BAR(); DEFPTRS();
        for (int r = gw; r < MP; r += 2 * NGW) { const int rb = r + NGW; const size_t oa = (size_t)r * D, ob = (size_t)rb * D;
            if (rb < MP) final_row2(Y + oa, Y + ob, X + oa, X + ob, out + O_Y + oa, out + O_Y + ob, nf_post + D, lane);
            else resid_norm_row(Y + oa, X + oa, nf_post + D, out + O_Y + oa, (float*)nullptr, (bf16*)nullptr, lane); }
        if (gw < MS) { const size_t o = (size_t)gw * D; resid_norm_row(YS + o, XS + o, nf_post + D, out + O_YS + o, (float*)nullptr, (bf16*)nullptr, lane); }
    }
#undef FFN_PHASES
#undef PROMPT_GEMM
#undef GRID_BAR
}

extern "C" void kernel_launch(void* const* d_in, const int* in_sizes, int n_in, void* d_out, int out_size, void* d_ws, size_t ws_size, hipStream_t stream) {
    static int grid = 0;
    if (grid == 0) {
        if (n_in != N_IN || out_size != (int)O_END || ws_size < WS_END) { fprintf(stderr, "kernel_launch: unexpected problem (n_in %d, out %d, ws %zu; need %d, %zu, >= %zu); nothing launched\n", n_in, out_size, ws_size, (int)N_IN, (size_t)O_END, (size_t)WS_END); grid = -1; return; }
        int dev = 0, cus = 0, per_cu = 0;
        if (hipGetDevice(&dev) != hipSuccess || hipDeviceGetAttribute(&cus, hipDeviceAttributeMultiprocessorCount, dev) != hipSuccess) { grid = -1; return; }
        if (hipFuncSetAttribute((const void*)fwd, hipFuncAttributeMaxDynamicSharedMemorySize, LDS_BYTES) != hipSuccess) { fprintf(stderr, "kernel_launch: hipFuncSetAttribute failed\n"); grid = -1; return; }
        if (hipOccupancyMaxActiveBlocksPerMultiprocessor(&per_cu, (const void*)fwd, NWAVES * 64, LDS_BYTES) != hipSuccess || per_cu < 1) { fprintf(stderr, "kernel_launch: occupancy query says %d blocks per CU\n", per_cu); (void)hipGetLastError(); grid = -1; return; }
        grid = cus;
    }
    if (grid < 0) return;
    if (hipMemsetAsync((char*)d_ws + WS_CTL, 0, CTL_ZERO_BYTES2, stream) != hipSuccess) return;
    Args a{};
    for (int i = 0; i < N_IN; ++i) a.in[i] = (const float*)d_in[i];
    a.out = (float*)d_out; a.ws = (unsigned char*)d_ws;
    hipLaunchKernelGGL(fwd, dim3(grid), dim3(NWAVES * 64), LDS_BYTES, stream, a);
}
```

```cpp
#include <hip/hip_runtime.h>
#include <cstdio>
#include <cstdint>
#ifndef PG8_WGM
#define PG8_WGM 8
#endif
#ifndef EPI_UP_I8
#define EPI_UP_I8 true
#endif
#ifndef EPI_IN_I8
#define EPI_IN_I8 false
#endif
#ifndef EPI_QKV_I8
#define EPI_QKV_I8 false
#endif
namespace pg8 {
#define PG8_LAS __attribute__((address_space(3)))
typedef unsigned short bf16_t;
typedef short bf16x8 __attribute__((ext_vector_type(8)));
typedef float f32x4 __attribute__((ext_vector_type(4)));
typedef unsigned u32x4 __attribute__((ext_vector_type(4)));
constexpr int BM = 256, BK = 64, HALF = 128, HTB = HALF * BK * 2  , STAGE_BYTES = 8 * HTB, NXCD = 8, WGM = PG8_WGM;

__host__ __device__ __forceinline__ int lds_byte(int r, int c) { const int st = (r >> 4) * 2 + (c >> 5), rr = r & 15, cc = c & 31, ob = rr * 64 + cc * 2; return st * 1024 + (ob ^ (((ob >> 9) & 1) << 5)); }
__host__ __device__ __forceinline__ void stage_rc(int b, int& R, int& C) { const int st = b / 1024, sb = b % 1024, swz = sb ^ (((sb >> 9) & 1) << 5); R = (st >> 1) * 16 + swz / 64; C = (st & 1) * 32 + (swz % 64) / 2; }
__host__ __device__ __forceinline__ int perm32(int rho) { const int n = rho >> 4, i = rho & 15; return 8 * (i >> 2) + 4 * n + (i & 3); }

struct Unit { int pm, pn; };
struct Gemm { const bf16_t* A; const bf16_t* Bt; int M, N, K; };

struct StaticOrder {
    int nM, nN, nwg, G, c;
    __host__ __device__ void init(int M, int N, int G_, int c_) { nM = M / BM; nN = N / BM; nwg = nM * nN; G = G_; c = c_; }
    __host__ __device__ bool next(int i, Unit& u) const {
        const long L = (long)i * G + c; if (L >= nwg) return false;
        int wgid = (int)L; { const int q = nwg / NXCD, r = nwg % NXCD, xcd = wgid % NXCD, off = wgid / NXCD; wgid = (xcd < r ? xcd * (q + 1) : r * (q + 1) + (xcd - r) * q) + off; }
        const int nig = WGM * nN, gid = wgid / nig, fm = gid * WGM, gsz = (nM - fm) < WGM ? (nM - fm) : WGM;
        u.pm = fm + ((wgid % nig) % gsz); u.pn = (wgid % nig) / gsz; return true;
    }
    __device__ __forceinline__ void a_ready(const Unit&) const {}
    __device__ __forceinline__ void done(const Unit&) const {}
};

__device__ __forceinline__ unsigned cvt_pk_bf16(float lo, float hi) { unsigned r; asm volatile("v_cvt_pk_bf16_f32 %0, %1, %2" : "=v"(r) : "v"(lo), "v"(hi)); return r; }
typedef float f32x2 __attribute__((ext_vector_type(2)));
__device__ __forceinline__ f32x2 gelu_pk(f32x2 v) {
    const f32x2 av = __builtin_elementwise_abs(v), d = av * 0.2316418882f + 1.0f;
    f32x2 t; t.x = __builtin_amdgcn_rcpf(d.x); t.y = __builtin_amdgcn_rcpf(d.y);
    f32x2 q = t * 0.5307027145f + (-0.7265760135f); q = q * t + 0.7107068705f; q = q * t + (-0.142248368f); q = q * t + 0.127414796f; q = q * t;
    const f32x2 s = (v * v) * (-0.72134752044f);
    f32x2 e; e.x = __builtin_amdgcn_exp2f(s.x); e.y = __builtin_amdgcn_exp2f(s.y);
    return v * 0.5f + av * (0.5f - q * e);
}


struct EpiF32 {
    static constexpr bool PERM = false, AFTER_DRAIN = false, APERM = false, I8 = false;
    float* C; int ldc; const float* bias;
    __device__ __forceinline__ void operator()(const f32x4 (&acc)[2][2][4][2], const Unit& u, int wr, int wc, int fr, int fq) const {
        const int row0 = u.pm * BM + wr * 64 + fr, col0 = u.pn * BM + wc * 32 + 4 * fq;
        f32x4 bv[2][2];
#pragma unroll
        for (int bj = 0; bj < 2; ++bj)
#pragma unroll
            for (int n = 0; n < 2; ++n) bv[bj][n] = bias ? *(const f32x4*)(bias + col0 + bj * HALF + n * 16) : (f32x4){0.f, 0.f, 0.f, 0.f};
#pragma unroll
        for (int ai = 0; ai < 2; ++ai)
#pragma unroll
            for (int m = 0; m < 4; ++m) { float* rowp = C + (size_t)(row0 + ai * HALF + m * 16) * ldc + col0;
#pragma unroll
                for (int bj = 0; bj < 2; ++bj)
#pragma unroll
                    for (int n = 0; n < 2; ++n) *(f32x4*)(rowp + bj * HALF + n * 16) = acc[ai][bj][m][n] + bv[bj][n]; }
    }
};
struct EpiBf16B {
    static constexpr bool PERM = true, AFTER_DRAIN = false, APERM = false, I8 = false;
    bf16_t* O; int ldc; const float* bias;
    __device__ __forceinline__ void operator()(const f32x4 (&acc)[2][2][4][2], const Unit& u, int wr, int wc, int fr, int fq) const {
        const int row0 = u.pm * BM + wr * 64 + fr, col0 = u.pn * BM + wc * 32 + 8 * fq;
        f32x4 bv[2][2];
#pragma unroll
        for (int bj = 0; bj < 2; ++bj)
#pragma unroll
            for (int n = 0; n < 2; ++n) bv[bj][n] = bias ? *(const f32x4*)(bias + col0 + bj * HALF + 4 * n) : (f32x4){0.f, 0.f, 0.f, 0.f};
#pragma unroll
        for (int ai = 0; ai < 2; ++ai)
#pragma unroll
            for (int m = 0; m < 4; ++m) { bf16_t* rowp = O + (size_t)(row0 + ai * HALF + m * 16) * ldc + col0;
#pragma unroll
                for (int bj = 0; bj < 2; ++bj) { const f32x4 v0 = acc[ai][bj][m][0] + bv[bj][0], v1 = acc[ai][bj][m][1] + bv[bj][1];
                    u32x4 w; w.x = cvt_pk_bf16(v0[0], v0[1]); w.y = cvt_pk_bf16(v0[2], v0[3]); w.z = cvt_pk_bf16(v1[0], v1[1]); w.w = cvt_pk_bf16(v1[2], v1[3]);
                    *(u32x4*)(rowp + bj * HALF) = w; } }
    }
};
struct EpiBf16BQ {
    static constexpr bool PERM = true, AFTER_DRAIN = false, APERM = false, I8 = true;
    bf16_t* O; int ldc; const float* sa; const float* sw;
    __device__ __forceinline__ void operator()(const f32x4 (&acc)[2][2][4][2], const Unit& u, int wr, int wc, int fr_in, int fq_in) const {
        int fr = fr_in, fq = fq_in; asm volatile("" : "+v"(fr), "+v"(fq));
        const int row0 = u.pm * BM + wr * 64 + fr, col0 = u.pn * BM + wc * 32 + 8 * fq;
        f32x4 sc[2][2];
#pragma unroll
        for (int bj = 0; bj < 2; ++bj)
#pragma unroll
            for (int n = 0; n < 2; ++n) sc[bj][n] = *(const f32x4*)(sw + col0 + bj * HALF + 4 * n);
#pragma unroll
        for (int ai = 0; ai < 2; ++ai)
#pragma unroll
            for (int m = 0; m < 4; ++m) { const float rr = sa[row0 + ai * HALF + m * 16]; bf16_t* rowp = O + (size_t)(row0 + ai * HALF + m * 16) * ldc + col0;
#pragma unroll
                for (int bj = 0; bj < 2; ++bj) { const f32x4 v0 = acc[ai][bj][m][0] * sc[bj][0] * rr, v1 = acc[ai][bj][m][1] * sc[bj][1] * rr;
                    u32x4 w; w.x = cvt_pk_bf16(v0[0], v0[1]); w.y = cvt_pk_bf16(v0[2], v0[3]); w.z = cvt_pk_bf16(v1[0], v1[1]); w.w = cvt_pk_bf16(v1[2], v1[3]);
                    *(u32x4*)(rowp + bj * HALF) = w; } }
    }
};
struct EpiGeluUV {
    static constexpr bool PERM = true, AFTER_DRAIN = false, APERM = false, I8 = EPI_IN_I8;
    bf16_t* U; bf16_t* V; float* vstat; const float* r2; const float* sw;
    __device__ __forceinline__ void operator()(const f32x4 (&acc0)[2][2][4][2], const Unit& u, int wr, int wc, int fr_in, int fq_in) const {
        int fr = fr_in, fq = fq_in; asm volatile("" : "+v"(fr), "+v"(fq));
        f32x4 (&acc)[2][2][4][2] = const_cast<f32x4 (&)[2][2][4][2]>(acc0);
#pragma unroll
        for (int ai = 0; ai < 2; ++ai)
#pragma unroll
            for (int m = 0; m < 4; ++m) { const float rr = r2[u.pm * BM + ai * HALF + wr * 64 + m * 16 + fr];
#pragma unroll
                for (int bj = 0; bj < 2; ++bj)
#pragma unroll
                    for (int n = 0; n < 2; ++n) acc[ai][bj][m][n] *= rr; }
        if (I8) {
#pragma unroll
            for (int bj = 0; bj < 2; ++bj)
#pragma unroll
                for (int n = 0; n < 2; ++n) { const f32x4 sc = *(const f32x4*)(sw + u.pn * BM + wc * 32 + 8 * fq + bj * HALF + 4 * n);
#pragma unroll
                    for (int ai = 0; ai < 2; ++ai)
#pragma unroll
                        for (int m = 0; m < 4; ++m) acc[ai][bj][m][n] *= sc; } }
        const bool isv = u.pn >= 16;
        const int row0 = u.pm * BM + wr * 64 + fr, col0 = (u.pn & 15) * BM + wc * 32 + 8 * fq;
        bf16_t* base = isv ? V : U;
#pragma unroll
        for (int ai = 0; ai < 2; ++ai)
#pragma unroll
            for (int m = 0; m < 4; ++m) { const int row = row0 + ai * HALF + m * 16; bf16_t* rowp = base + (size_t)row * 4096 + col0; float s = 0.f, q = 0.f;
#pragma unroll
                for (int bj = 0; bj < 2; ++bj) { f32x4 v0 = acc[ai][bj][m][0], v1 = acc[ai][bj][m][1];
                    { f32x2 a = gelu_pk((f32x2){v0[0], v0[1]}), b = gelu_pk((f32x2){v0[2], v0[3]}), c = gelu_pk((f32x2){v1[0], v1[1]}), d = gelu_pk((f32x2){v1[2], v1[3]});
                      v0 = (f32x4){a.x, a.y, b.x, b.y}; v1 = (f32x4){c.x, c.y, d.x, d.y}; }
                    s += ((v0[0] + v0[1]) + (v0[2] + v0[3])) + ((v1[0] + v1[1]) + (v1[2] + v1[3]));
                    q += ((v0[0] * v0[0] + v0[1] * v0[1]) + (v0[2] * v0[2] + v0[3] * v0[3])) + ((v1[0] * v1[0] + v1[1] * v1[1]) + (v1[2] * v1[2] + v1[3] * v1[3]));
                    u32x4 w; w.x = cvt_pk_bf16(v0[0], v0[1]); w.y = cvt_pk_bf16(v0[2], v0[3]); w.z = cvt_pk_bf16(v1[0], v1[1]); w.w = cvt_pk_bf16(v1[2], v1[3]);
                    *(u32x4*)(rowp + bj * HALF) = w; }
                if (isv) { s += __shfl_xor(s, 16); s += __shfl_xor(s, 32); q += __shfl_xor(q, 16); q += __shfl_xor(q, 32);
                    if (fq == 0) *(f32x2*)(vstat + ((size_t)row * 64 + (u.pn - 16) * 4 + wc) * 2) = (f32x2){s, q}; } }
    }
};
__device__ __forceinline__ float dpp_shr1(float old, float x) { return __int_as_float(__builtin_amdgcn_update_dpp(__float_as_int(old), __float_as_int(x), 0x111, 0xf, 0xf, false)); }
struct EpiUpConv {
    static constexpr bool PERM = true, AFTER_DRAIN = false, APERM = true, I8 = EPI_UP_I8;
    bf16_t* ACT; float* haloB; float* haloT; const float* cw; const float* cb; PG8_LAS float* xh; const float* r2; const float* sw;
    __device__ __forceinline__ void operator()(const f32x4 (&acc0)[2][2][4][2], const Unit& u, int wr, int wc, int fr_in, int fq_in) const {
        int fr = fr_in, fq = fq_in; asm volatile("" : "+v"(fr), "+v"(fq));
        f32x4 (&acc)[2][2][4][2] = const_cast<f32x4 (&)[2][2][4][2]>(acc0);
        { const f32x4 ra = *(const f32x4*)(r2 + u.pm * BM + 128 * wr + 8 * fr), rb = *(const f32x4*)(r2 + u.pm * BM + 128 * wr + 8 * fr + 4);
#pragma unroll
          for (int ai = 0; ai < 2; ++ai)
#pragma unroll
              for (int m = 0; m < 4; ++m) { const float rr = ai ? rb[m] : ra[m];
#pragma unroll
                  for (int bj = 0; bj < 2; ++bj)
#pragma unroll
                      for (int n = 0; n < 2; ++n) acc[ai][bj][m][n] *= rr; }
          if (I8) {
#pragma unroll
              for (int bj = 0; bj < 2; ++bj)
#pragma unroll
                  for (int n = 0; n < 2; ++n) { const f32x4 sc = *(const f32x4*)(sw + u.pn * 256 + wc * 32 + 8 * fq + bj * 128 + 4 * n);
#pragma unroll
                      for (int ai = 0; ai < 2; ++ai)
#pragma unroll
                          for (int m = 0; m < 4; ++m) acc[ai][bj][m][n] *= sc; } } }
        const int colh = u.pn * 128 + wc * 32 + 8 * fq;
        const int colt = u.pn * 256 + wc * 32 + 8 * fq;
        if (wr == 1 && fr == 15) {
#pragma unroll
            for (int t = 0; t < 2; ++t) { float* d = haloB + (size_t)(u.pm * 2 + t) * 22016 + colt;
#pragma unroll
                for (int bj = 0; bj < 2; ++bj)
#pragma unroll
                    for (int n = 0; n < 2; ++n) *(f32x4*)(d + bj * 128 + 4 * n) = acc[1][bj][2 + t][n];
            }
        }
        if (wr == 0 && fr == 0) {
#pragma unroll
            for (int t = 0; t < 2; ++t) { float* d = haloT + (size_t)(u.pm * 2 + t) * 22016 + colt;
#pragma unroll
                for (int bj = 0; bj < 2; ++bj)
#pragma unroll
                    for (int n = 0; n < 2; ++n) *(f32x4*)(d + bj * 128 + 4 * n) = acc[0][bj][t][n]; }
        }
        PG8_LAS float* xp = xh + (wc * 4 + fq) * 32;
        if (wr == 0 && fr == 15) {
#pragma unroll
            for (int t = 0; t < 2; ++t)
#pragma unroll
                for (int bj = 0; bj < 2; ++bj)
#pragma unroll
                    for (int n = 0; n < 2; ++n) *(PG8_LAS f32x4*)(xp + t * 16 + bj * 8 + n * 4) = acc[1][bj][2 + t][n];
        }
        asm volatile("s_waitcnt lgkmcnt(0)" ::: "memory"); __builtin_amdgcn_s_barrier(); asm volatile("" ::: "memory");
        unsigned pk0[8][2];
        f32x2 nl = (f32x2){-1.44269504089f, -1.44269504089f}; asm volatile("" : "+v"(nl)); const f32x4 nl2e = (f32x4){nl.x, nl.y, nl.x, nl.y};
#pragma unroll
        for (int n = 0; n < 2; ++n) {
            f32x4 wg[3], wv[3];
#pragma unroll
            for (int t = 0; t < 3; ++t) { wg[t] = *(const f32x4*)(cw + (size_t)t * 22016 + colh + 4 * n); wv[t] = *(const f32x4*)(cw + (size_t)t * 22016 + 11008 + colh + 4 * n); }
            const f32x4 bg = *(const f32x4*)(cb + colh + 4 * n), bv = *(const f32x4*)(cb + 11008 + colh + 4 * n);
            f32x4 og2 = (f32x4){0.f, 0.f, 0.f, 0.f}, og1 = og2, ov2 = og2, ov1 = og2;
            if (wr == 1) { og2 = *(PG8_LAS const f32x4*)(xp + n * 4); og1 = *(PG8_LAS const f32x4*)(xp + 16 + n * 4); ov2 = *(PG8_LAS const f32x4*)(xp + 8 + n * 4); ov1 = *(PG8_LAS const f32x4*)(xp + 24 + n * 4); }
            f32x4 pg2, pg1, pv2, pv1;
#pragma unroll
            for (int i = 0; i < 4; ++i) { pg2[i] = dpp_shr1(og2[i], acc[1][0][2][n][i]); pg1[i] = dpp_shr1(og1[i], acc[1][0][3][n][i]); pv2[i] = dpp_shr1(ov2[i], acc[1][1][2][n][i]); pv1[i] = dpp_shr1(ov1[i], acc[1][1][3][n][i]); }
#pragma unroll
            for (int e = 0; e < 8; ++e) { const f32x4 xg = acc[e >> 2][0][e & 3][n], xv = acc[e >> 2][1][e & 3][n];
                const f32x4 cg = bg + wg[0] * pg2 + wg[1] * pg1 + wg[2] * xg, cv = bv + wv[0] * pv2 + wv[1] * pv1 + wv[2] * xv;
                const f32x4 tt = cg * nl2e; f32x4 ee, rc;
#pragma unroll
                for (int i = 0; i < 4; ++i) ee[i] = __builtin_amdgcn_exp2f(tt[i]);
                ee = ee + 1.0f;
#pragma unroll
                for (int i = 0; i < 4; ++i) rc[i] = __builtin_amdgcn_rcpf(ee[i]);
                const f32x4 r = cg * cv * rc;
                pg2 = pg1; pg1 = xg; pv2 = pv1; pv1 = xv;
                const unsigned lo = cvt_pk_bf16(r[0], r[1]), hi = cvt_pk_bf16(r[2], r[3]);
                if (n == 0) { pk0[e][0] = lo; pk0[e][1] = hi; }
                else { u32x4 w; w.x = pk0[e][0]; w.y = pk0[e][1]; w.z = lo; w.w = hi;
                    *(u32x4*)(ACT + (size_t)(u.pm * BM + wr * 128 + fr * 8 + e) * 11008 + colh) = w; } }
        }
    }
};
struct EpiQkv {
    static constexpr bool PERM = true, AFTER_DRAIN = false, APERM = false, I8 = EPI_QKV_I8;
    bf16_t* QKV; const float* bias; float* wk; float* wv; const float* r2; const float* sw;
    __device__ __forceinline__ void operator()(const f32x4 (&acc0)[2][2][4][2], const Unit& u, int wr, int wc, int fr_in, int fq_in) const {
        int fr = fr_in, fq = fq_in; asm volatile("" : "+v"(fr), "+v"(fq));
        f32x4 (&acc)[2][2][4][2] = const_cast<f32x4 (&)[2][2][4][2]>(acc0);
#pragma unroll
        for (int ai = 0; ai < 2; ++ai)
#pragma unroll
            for (int m = 0; m < 4; ++m) { const float rr = r2[u.pm * BM + ai * HALF + wr * 64 + m * 16 + fr];
#pragma unroll
                for (int bj = 0; bj < 2; ++bj)
#pragma unroll
                    for (int n = 0; n < 2; ++n) acc[ai][bj][m][n] *= rr; }
        if (I8) {
#pragma unroll
            for (int bj = 0; bj < 2; ++bj)
#pragma unroll
                for (int n = 0; n < 2; ++n) { const f32x4 sc = *(const f32x4*)(sw + u.pn * BM + wc * 32 + 8 * fq + bj * HALF + 4 * n);
#pragma unroll
                    for (int ai = 0; ai < 2; ++ai)
#pragma unroll
                        for (int m = 0; m < 4; ++m) acc[ai][bj][m][n] *= sc; } }
        const int row0 = u.pm * BM + wr * 64 + fr, col0 = u.pn * BM + wc * 32 + 8 * fq;
        const bool win = ((u.pm & 7) == 7) && (u.pn >= 16);
        f32x4 bv[2][2];
#pragma unroll
        for (int bj = 0; bj < 2; ++bj)
#pragma unroll
            for (int n = 0; n < 2; ++n) bv[bj][n] = *(const f32x4*)(bias + col0 + bj * HALF + 4 * n);
#pragma unroll
        for (int ai = 0; ai < 2; ++ai)
#pragma unroll
            for (int m = 0; m < 4; ++m) { bf16_t* rowp = QKV + (size_t)(row0 + ai * HALF + m * 16) * 5120 + col0;
#pragma unroll
                for (int bj = 0; bj < 2; ++bj) { const f32x4 v0 = acc[ai][bj][m][0] + bv[bj][0], v1 = acc[ai][bj][m][1] + bv[bj][1];
                    u32x4 w; w.x = cvt_pk_bf16(v0[0], v0[1]); w.y = cvt_pk_bf16(v0[2], v0[3]); w.z = cvt_pk_bf16(v1[0], v1[1]); w.w = cvt_pk_bf16(v1[2], v1[3]);
                    *(u32x4*)(rowp + bj * HALF) = w;
                    if (win && ai == 1) { float* dst = (u.pn >= 18 ? wv : wk) + (size_t)((u.pm >> 3) * 128 + wr * 64 + m * 16 + fr) * 512 + ((u.pn - 16) & 1) * 256 + wc * 32 + 8 * fq + bj * HALF;
                        *(f32x4*)dst = v0; *(f32x4*)(dst + 4) = v1; } } }
    }
};
typedef int i32x4 __attribute__((ext_vector_type(4)));
template <bool I8> __device__ __forceinline__ f32x4 pg8_mma(bf16x8 b, bf16x8 a, f32x4 c) {
    if constexpr (I8) return __builtin_bit_cast(f32x4, __builtin_amdgcn_mfma_i32_16x16x64_i8(__builtin_bit_cast(i32x4, b), __builtin_bit_cast(i32x4, a), __builtin_bit_cast(i32x4, c), 0, 0, 0));
    else return __builtin_amdgcn_mfma_f32_16x16x32_bf16(b, a, c, 0, 0, 0);
}
template <class Epi, class Sched, bool ALIGN_EPI = false, bool SP2 = false>
__device__ __forceinline__ void gemm_phase(PG8_LAS unsigned char* lds, const Gemm g, const Sched& S, const Epi& E) {
    int tid_l = threadIdx.x; asm volatile("" : "+v"(tid_l));
    const int tid = tid_l, wid = __builtin_amdgcn_readfirstlane(tid >> 6), lane = tid & 63, wr = wid >> 2, wc = wid & 3, fr = lane & 15, fq = lane >> 4;
    const int K = g.K, nt = K / BK;
    unsigned voffA[2], voffB[2];
#pragma unroll
    for (int i = 0; i < 2; ++i) { int R, C; stage_rc(tid * 16 + i * 8192, R, C); const int Rb = Epi::PERM ? ((R & ~31) + perm32(R & 31)) : R;
        const int Ra = Epi::APERM ? (128 * (R >> 6) + 8 * (R & 15) + ((R >> 4) & 3)) : R;
        voffA[i] = (unsigned)(Ra * K + C) * 2u; voffB[i] = (unsigned)(Rb * K + C) * 2u; }
    const size_t kstep = (size_t)(BK * 2);
    const size_t hstep = (size_t)HALF * K * 2;
    const size_t hstepA = Epi::APERM ? (size_t)4 * K * 2 : hstep;
    const size_t tstep = 2 * hstep;
    const unsigned ldsw = (unsigned)wid * 1024u;
    const int aoff = lds_byte(wr * 64 + fr, fq * 8), boff = lds_byte(wc * 32 + fr, fq * 8);
#define PG8_SA(b, h) (((b) * 2 + (h)) * HTB)
#define PG8_SB(b, h) ((4 + (b) * 2 + (h)) * HTB)
#define PG8_STAGE(bufoff, gbase, voff) do { _Pragma("unroll") for (int _i = 0; _i < 2; ++_i) \
        __builtin_amdgcn_global_load_lds((const unsigned*)((const char*)(gbase) + (voff)[_i]), (PG8_LAS unsigned*)(lds + (bufoff) + ldsw + _i * 8192), 16, 0, 0); } while (0)
#define PG8_LDA(dst, b, h) do { _Pragma("unroll") for (int m = 0; m < 4; ++m) _Pragma("unroll") for (int k = 0; k < 2; ++k) dst[m][k] = *(const PG8_LAS bf16x8*)(lds + PG8_SA(b, h) + aoff + m * 2048 + k * 1024); } while (0)
#define PG8_LDB(dst, b, h) do { _Pragma("unroll") for (int n = 0; n < 2; ++n) _Pragma("unroll") for (int k = 0; k < 2; ++k) dst[n][k] = *(const PG8_LAS bf16x8*)(lds + PG8_SB(b, h) + boff + n * 2048 + k * 1024); } while (0)
#define PG8_MMA(ai, bj, At, Bt) do { __builtin_amdgcn_s_setprio(1); _Pragma("unroll") for (int m = 0; m < 4; ++m) _Pragma("unroll") for (int n = 0; n < 2; ++n) _Pragma("unroll") for (int k = 0; k < 2; ++k) \
        acc[ai][bj][m][n] = pg8_mma<Epi::I8>(Bt[n][k], At[m][k], acc[ai][bj][m][n]); __builtin_amdgcn_s_setprio(0); } while (0)
#define PG8_WAIT_V(n) asm volatile("s_waitcnt vmcnt(" #n ")" ::: "memory")
#define PG8_WAIT_L(n) asm volatile("s_waitcnt lgkmcnt(" #n ")" ::: "memory")
#define PG8_BAR __builtin_amdgcn_s_barrier()
#define PG8_SCHED __builtin_amdgcn_sched_barrier(0)
    Unit cur, nxt; int ui = 0;
    if (!S.next(0, cur)) return;
    f32x4 acc[2][2][4][2];
#pragma unroll
    for (int a = 0; a < 2; ++a)
#pragma unroll
        for (int b = 0; b < 2; ++b)
#pragma unroll
            for (int m = 0; m < 4; ++m)
#pragma unroll
                for (int n = 0; n < 2; ++n) acc[a][b][m][n] = (f32x4){0.f, 0.f, 0.f, 0.f};
    bf16x8 At[4][2], B0[2][2], B1[2][2];
    const char* cA = (const char*)g.A + (size_t)cur.pm * tstep; const char* cB = (const char*)g.Bt + (size_t)cur.pn * tstep;
    S.a_ready(cur);
    if constexpr (SP2) {
        PG8_STAGE(PG8_SB(0, 0), cB, voffB); PG8_STAGE(PG8_SB(0, 1), cB + hstep, voffB); PG8_STAGE(PG8_SA(0, 0), cA, voffA); PG8_STAGE(PG8_SA(0, 1), cA + hstepA, voffA);
        if (wr == 1) PG8_BAR;
        PG8_WAIT_V(2); PG8_BAR;
        PG8_STAGE(PG8_SB(1, 0), cB + kstep, voffB); PG8_STAGE(PG8_SA(1, 0), cA + kstep, voffA); PG8_STAGE(PG8_SB(1, 1), cB + hstep + kstep, voffB);
        PG8_WAIT_V(6); PG8_BAR;
    } else {
        PG8_STAGE(PG8_SB(0, 0), cB, voffB); PG8_STAGE(PG8_SA(0, 0), cA, voffA); PG8_STAGE(PG8_SB(0, 1), cB + hstep, voffB); PG8_STAGE(PG8_SA(0, 1), cA + hstepA, voffA);
        if (wr == 1) PG8_BAR;
        PG8_WAIT_V(4); PG8_BAR;
        PG8_STAGE(PG8_SB(1, 0), cB + kstep, voffB); PG8_STAGE(PG8_SA(1, 0), cA + kstep, voffA); PG8_STAGE(PG8_SB(1, 1), cB + hstep + kstep, voffB);
        PG8_WAIT_V(6); PG8_BAR;
    }
    for (;;) {
        const bool has_next = S.next(ui + 1, nxt);
        const char* nA = has_next ? (const char*)g.A + (size_t)nxt.pm * tstep : cA; const char* nB = has_next ? (const char*)g.Bt + (size_t)nxt.pn * tstep : cB;
        for (int t = 0; t < nt; t += 2) {
            const bool last = (t == nt - 2);
            const char* a1 = cA + (size_t)(t + 1) * kstep;
            const char* a2 = last ? nA : cA + (size_t)(t + 2) * kstep; const char* b2 = last ? nB : cB + (size_t)(t + 2) * kstep;
            const char* a3 = a2 + kstep; const char* b3 = b2 + kstep;
            if (last && has_next) S.a_ready(nxt);
            if constexpr (SP2) {
            PG8_LDB(B0, 0, 0); PG8_LDB(B1, 0, 1); PG8_SCHED; PG8_LDA(At, 0, 0); PG8_STAGE(PG8_SA(1, 1), a1 + hstepA, voffA);
            PG8_WAIT_V(8); PG8_WAIT_L(0); PG8_BAR; PG8_MMA(0, 0, At, B0); PG8_MMA(0, 1, At, B1); PG8_BAR; PG8_SCHED;
            PG8_LDA(At, 0, 1); PG8_STAGE(PG8_SB(0, 0), b2, voffB); PG8_STAGE(PG8_SB(0, 1), b2 + hstep, voffB); PG8_STAGE(PG8_SA(0, 0), a2, voffA);
            PG8_WAIT_V(8); PG8_WAIT_L(0); PG8_BAR; PG8_MMA(1, 0, At, B0); PG8_MMA(1, 1, At, B1); PG8_BAR; PG8_SCHED;
            PG8_LDB(B0, 1, 0); PG8_LDB(B1, 1, 1); PG8_SCHED; PG8_LDA(At, 1, 0); PG8_STAGE(PG8_SA(0, 1), a2 + hstepA, voffA);
            PG8_WAIT_V(8); PG8_WAIT_L(0); PG8_BAR; PG8_MMA(0, 0, At, B0); PG8_MMA(0, 1, At, B1); PG8_BAR; PG8_SCHED;
            PG8_LDA(At, 1, 1); PG8_STAGE(PG8_SB(1, 0), b3, voffB); PG8_STAGE(PG8_SB(1, 1), b3 + hstep, voffB); PG8_STAGE(PG8_SA(1, 0), a3, voffA);
            PG8_WAIT_V(8); PG8_WAIT_L(0); PG8_BAR; PG8_MMA(1, 0, At, B0); PG8_MMA(1, 1, At, B1); PG8_BAR; PG8_SCHED;
            } else {
            PG8_LDB(B0, 0, 0); PG8_SCHED; PG8_LDA(At, 0, 0); PG8_STAGE(PG8_SA(1, 1), a1 + hstepA, voffA);
            PG8_WAIT_L(8); PG8_BAR; PG8_WAIT_L(0); PG8_MMA(0, 0, At, B0); PG8_BAR; PG8_SCHED;
            PG8_LDB(B1, 0, 1); PG8_STAGE(PG8_SB(0, 0), b2, voffB);
            PG8_BAR; PG8_WAIT_L(0); PG8_MMA(0, 1, At, B1); PG8_BAR;
            PG8_LDA(At, 0, 1); PG8_STAGE(PG8_SA(0, 0), a2, voffA);
            PG8_BAR; PG8_WAIT_L(0); PG8_MMA(1, 0, At, B0); PG8_BAR; PG8_SCHED;
            PG8_STAGE(PG8_SB(0, 1), b2 + hstep, voffB);
            PG8_WAIT_V(6); PG8_BAR; PG8_MMA(1, 1, At, B1); PG8_BAR;
            PG8_LDB(B0, 1, 0); PG8_SCHED; PG8_LDA(At, 1, 0); PG8_STAGE(PG8_SA(0, 1), a2 + hstepA, voffA);
            PG8_WAIT_L(8); PG8_BAR; PG8_WAIT_L(0); PG8_MMA(0, 0, At, B0); PG8_BAR; PG8_SCHED;
            PG8_LDB(B1, 1, 1); PG8_STAGE(PG8_SB(1, 0), b3, voffB);
            PG8_BAR; PG8_WAIT_L(0); PG8_MMA(0, 1, At, B1); PG8_BAR;
            PG8_LDA(At, 1, 1); PG8_STAGE(PG8_SA(1, 0), a3, voffA);
            PG8_BAR; PG8_WAIT_L(0); PG8_MMA(1, 0, At, B0); PG8_BAR; PG8_SCHED;
            PG8_STAGE(PG8_SB(1, 1), b3 + hstep, voffB);
            PG8_WAIT_V(6); PG8_BAR; PG8_MMA(1, 1, At, B1); PG8_BAR;
            }
        }
        if constexpr (ALIGN_EPI) { if (wr == 0) PG8_BAR; }
        if constexpr (Epi::I8) {
#pragma unroll
            for (int a = 0; a < 2; ++a)
#pragma unroll
                for (int b = 0; b < 2; ++b)
#pragma unroll
                    for (int m = 0; m < 4; ++m)
#pragma unroll
                        for (int n = 0; n < 2; ++n) acc[a][b][m][n] = __builtin_convertvector(__builtin_bit_cast(i32x4, acc[a][b][m][n]), f32x4); }
        if constexpr (!Epi::AFTER_DRAIN) { E(acc, cur, wr, wc, fr, fq); S.done(cur); }
        if (!has_next) break;
#pragma unroll
        for (int a = 0; a < 2; ++a)
#pragma unroll
            for (int b = 0; b < 2; ++b)
#pragma unroll
                for (int m = 0; m < 4; ++m)
#pragma unroll
                    for (int n = 0; n < 2; ++n) acc[a][b][m][n] = (f32x4){0.f, 0.f, 0.f, 0.f};
        cur = nxt; cA = nA; cB = nB; ++ui;
        if constexpr (ALIGN_EPI) { if (wr == 1) PG8_BAR; }
    }
    PG8_WAIT_V(0);
    if constexpr (!ALIGN_EPI) { if (wr == 0) PG8_BAR; }
    PG8_BAR;
    if constexpr (Epi::AFTER_DRAIN) { E.fused(acc, cur, wr, wc, fr, fq, lds, wid, lane); S.done(cur); }
#undef PG8_SA
#undef PG8_SB
#undef PG8_STAGE
#undef PG8_LDA
#undef PG8_LDB
#undef PG8_MMA
#undef PG8_WAIT_V
#undef PG8_WAIT_L
#undef PG8_BAR
#undef PG8_SCHED
}
}
#define GAS __attribute__((address_space(1)))
#define LAS __attribute__((address_space(3)))
typedef unsigned short bf16;
typedef unsigned v4u __attribute__((ext_vector_type(4)));
typedef float f32x4 __attribute__((ext_vector_type(4)));
typedef short bf16x8 __attribute__((ext_vector_type(8)));
typedef GAS unsigned gu32;
typedef GAS unsigned long long gu64;
#define RLX_AGENT __ATOMIC_RELAXED, __HIP_MEMORY_SCOPE_AGENT
#define LDS_WAIT() asm volatile("s_waitcnt lgkmcnt(0)" ::: "memory")
#define VM_WAIT() asm volatile("s_waitcnt vmcnt(0)" ::: "memory")
__device__ __forceinline__ unsigned long long rt() { return __builtin_amdgcn_s_memrealtime(); }
__device__ __forceinline__ unsigned f2bf(float f) { unsigned u = __builtin_bit_cast(unsigned, f); return (u + 0x7fffu + ((u >> 16) & 1u)) >> 16; }
__device__ __forceinline__ unsigned pk2(float lo, float hi) { return f2bf(lo) | (f2bf(hi) << 16); }

#define XB_TMO      128
#define XB_XCNT(j)  (256  + 64 * (j))
#define XB_XSUB(j)  (1280 + 64 * (j))
#define XB_XGEN(j)  (2304 + 64 * (j))
#define XB_TOP      3328
#define XB_TOPGEN   3392
#define XCD_BAR_WORDS 3456
#define XB_SPIN_CAP (1u << 18)

__device__ __forceinline__ unsigned xb_ld(unsigned* p)              { return __hip_atomic_load(p, __ATOMIC_RELAXED, __HIP_MEMORY_SCOPE_AGENT); }
__device__ __forceinline__ unsigned xb_add(unsigned* p, unsigned v) { return __hip_atomic_fetch_add(p, v, __ATOMIC_RELAXED, __HIP_MEMORY_SCOPE_AGENT); }
__device__ __forceinline__ unsigned xb_xcc_id() { return (unsigned)__builtin_amdgcn_s_getreg((3 << 11) | 20) & 0xFu; }
#define XB_SPIN(cond, bar) do { unsigned _sp = 0; while (cond) { __builtin_amdgcn_s_sleep(1); \
    if ((++_sp & 255u) == 0u) { if (xb_ld(&(bar)[XB_TMO])) break; if (_sp > XB_SPIN_CAP) { atomicAdd(&(bar)[XB_TMO], 1u); break; } } } } while (0)

struct XcdBarrier {
    unsigned* bar; unsigned x;
    volatile LAS unsigned* st;
};

__device__ __forceinline__ XcdBarrier xcd_barrier_post(unsigned* bar, volatile LAS unsigned* st) {
    XcdBarrier b; b.bar = bar; b.x = xb_xcc_id(); b.st = st;
    if (threadIdx.x == 0) (void)xb_add(&bar[XB_XCNT(b.x)], 1u);
    return b;
}
__device__ __forceinline__ void xcd_barrier_complete(unsigned* bar, unsigned x, unsigned& nloc, unsigned& nx) {
    const unsigned G = gridDim.x * gridDim.y * gridDim.z;
    unsigned sum, cnt, mine, sp = 0u;
    for (;;) {
        sum = 0u; cnt = 0u; mine = 0u;
#pragma unroll
        for (unsigned j = 0; j < 16; ++j) { const unsigned c = xb_ld(&bar[XB_XCNT(j)]); sum += c; cnt += (c > 0u) ? 1u : 0u; mine = (j == x) ? c : mine; }
        if (sum == G) break;
        __builtin_amdgcn_s_sleep(1);
        if ((++sp & 255u) == 0u) { if (xb_ld(&bar[XB_TMO])) break; if (sp > XB_SPIN_CAP) { atomicAdd(&bar[XB_TMO], 1u); break; } }
    }
    nloc = mine > 0u ? mine : 1u; nx = cnt > 0u ? cnt : 1u;
}

__device__ __forceinline__ void xcd_barrier(const XcdBarrier& b) {
    asm volatile("s_waitcnt vmcnt(0)" ::: "memory");
    __syncthreads();
    if (threadIdx.x == 0) {
        unsigned* bar = b.bar;
        __builtin_amdgcn_s_waitcnt(0);
        unsigned nloc = b.st[0], nx = b.st[1];
        if (nloc == 0u) { xcd_barrier_complete(bar, b.x, nloc, nx); b.st[0] = nloc; b.st[1] = nx; }
        const unsigned old = xb_add(&bar[XB_XSUB(b.x)], 1u);
        const unsigned gen = old / nloc;
        if (old + 1u == (gen + 1u) * nloc) {
            __builtin_amdgcn_fence(__ATOMIC_RELEASE, "agent");
            asm volatile("s_waitcnt vmcnt(0)" ::: "memory");
            const unsigned og = xb_add(&bar[XB_TOP], 1u);
            const unsigned tg = og / nx;
            if (og + 1u == (tg + 1u) * nx) xb_add(&bar[XB_TOPGEN], 1u);
            else XB_SPIN(xb_ld(&bar[XB_TOPGEN]) == tg, bar);
            __builtin_amdgcn_fence(__ATOMIC_ACQUIRE, "agent");
            xb_add(&bar[XB_XGEN(b.x)], 1u);
            asm volatile("s_waitcnt vmcnt(0)" ::: "memory");
        } else {
            XB_SPIN(xb_ld(&bar[XB_XGEN(b.x)]) == gen, bar);
            __builtin_amdgcn_fence(__ATOMIC_ACQUIRE, "agent");
            asm volatile("s_waitcnt vmcnt(0)" ::: "memory");
        }
    }
    __syncthreads();
}

constexpr int D = 4096, MP = 8192, MS = 32, SEQ = 2048, NBATCH = 4;
constexpr int DFF = 11008, DFF2 = 22016, NQKV = 5120, DZ = 8192;
constexpr float NORM_EPS = 1e-6f, ATTN_SCALE = 0.125f;
constexpr int NWAVES = 8;

enum { I_XP = 0, I_XS, I_CK, I_CV, I_SC, I_NMPRE, I_NMPOST, I_NFPRE, I_NFPOST, I_WIN, I_LNG, I_LNB, I_WS, I_BS, I_WOUT, I_WQKV, I_BQKV, I_SINK, I_WO, I_BO, I_WUP, I_CW, I_CB, I_WDN, N_IN };
constexpr size_t O_Y = 0, O_YS = O_Y + (size_t)MP * D, O_GVP = O_YS + (size_t)MS * D, O_GVS = O_GVP + (size_t)NBATCH * 128 * D, O_WKP = O_GVS + (size_t)MS * D,
                 O_WVP = O_WKP + (size_t)NBATCH * 128 * 512, O_WKS = O_WVP + (size_t)NBATCH * 128 * 512, O_WVS = O_WKS + (size_t)MS * 128 * 512, O_CVP = O_WVS + (size_t)MS * 128 * 512,
                 O_CVS = O_CVP + (size_t)2 * NBATCH * 2 * DFF2, O_END = O_CVS + (size_t)2 * MS * 2 * DFF2;
static_assert(O_END == 43802624, "output size");

constexpr size_t MiB = 1u << 20;
constexpr size_t WS_CTL = 0, CTL_ZERO_BYTES = 32768;
constexpr size_t WS_WIN = 1 * MiB;
constexpr size_t WS_WOUT = WS_WIN + 64 * MiB;
constexpr size_t WS_WQKV = WS_WOUT + 32 * MiB;
constexpr size_t WS_WO = WS_WQKV + 40 * MiB;
constexpr size_t WS_WUP = WS_WO + 32 * MiB;
constexpr size_t WS_WDN = WS_WUP + 2 * 172 * MiB;
constexpr size_t WS_HN = WS_WDN + 2 * 86 * MiB;
constexpr size_t WS_U = WS_HN + 64 * MiB;
constexpr size_t WS_V = WS_U + 64 * MiB;
constexpr size_t WS_VSTAT = WS_V + 64 * MiB;
constexpr size_t WS_GATED = WS_VSTAT + 4 * MiB;
constexpr size_t WS_Y = WS_GATED + 64 * MiB;
constexpr size_t WS_X = WS_Y + 128 * MiB;
constexpr size_t WS_RQ = WS_X + 65 * MiB;
constexpr size_t WS_SW = WS_X + 66 * MiB;
constexpr size_t WS_XQ = WS_X + 68 * MiB;
constexpr size_t WS_R2 = WS_X + 64 * MiB;
constexpr size_t WS_HALOB = WS_X + 128 * MiB;
constexpr size_t WS_HALOT = WS_HALOB + 6 * MiB;
constexpr size_t WS_ACT = WS_HALOT + 6 * MiB;
constexpr size_t WS_QKV = WS_ACT + 172 * MiB;
constexpr size_t WS_WQUP = WS_QKV + 80 * MiB;
constexpr size_t WS_WQIN = WS_WQUP + 172 * MiB;
constexpr size_t WS_WQQKV = WS_WQIN + 32 * MiB;
constexpr size_t WS_SMP = WS_WQQKV + 20 * MiB;
constexpr size_t SM_HS = 0;
constexpr size_t SM_ZS = SM_HS + 512 * 1024;
constexpr size_t SM_GS = SM_ZS + 1024 * 1024;
constexpr size_t SM_YS = SM_GS + 256 * 1024;
constexpr size_t SM_XS = SM_YS + 512 * 1024;
constexpr size_t SM_HHS = SM_XS + 512 * 1024;
constexpr size_t SM_ACTS = SM_HHS + 3 * 1024 * 1024;
constexpr size_t SM_QKVS = SM_ACTS + 1024 * 1024;
constexpr size_t SM_HSQ = 7680 * 1024;
constexpr size_t SM_SAS = 7936 * 1024 + 1024;
constexpr size_t SM_HSS = 7936 * 1024;
static_assert(SM_QKVS + 32 * 5120 * 4 <= SM_HSQ && SM_HSQ + 48 * 4096 <= SM_HSS && SM_SAS + 256 <= 8 * MiB, "sample buffers");
constexpr size_t WS_WQDN = WS_SMP + 8 * MiB;
constexpr size_t WS_ACTQ = WS_U;
constexpr size_t WS_SA = WS_X + 67 * MiB;
constexpr size_t WS_END = WS_WQDN + 86 * MiB;
static_assert(SM_QKVS + 32 * 5120 * 4 <= 8 * MiB, "sample buffers");
constexpr int CW_CMAX = 8192;
constexpr int NQCOL = 2 * 22016 + 8192 + 5120 + 2 * 4096;
constexpr int QC_DN = 2 * 22016 + 8192 + 5120;
constexpr size_t CTL_ZERO_BYTES2 = (size_t)(CW_CMAX + NQCOL) * 4;
constexpr int CW_ITEM = 7680;
constexpr int CW_BAR = 4096;
static_assert((CW_BAR + 3456) * 4 <= (int)CTL_ZERO_BYTES, "barrier words inside the per-call memset");

constexpr int RING_OFF = 0, RING_BYTES = 131072;
constexpr int LDSCTL_OFF = RING_BYTES, MISC_OFF = LDSCTL_OFF + 320;
constexpr int XH_OFF = RING_BYTES + 1024;
constexpr int LDS_BYTES = 147456;
static_assert(MISC_OFF + 128 <= XH_OFF && XH_OFF + 2048 <= LDS_BYTES, "LDS map");

typedef short v4i16_t __attribute__((ext_vector_type(4)));
typedef float f32x2g __attribute__((ext_vector_type(2)));
typedef unsigned u32x2g __attribute__((ext_vector_type(2)));
__device__ __forceinline__ float bflo(unsigned w) { return __uint_as_float(w << 16); }
__device__ __forceinline__ float bfhi(unsigned w) { return __uint_as_float(w & 0xffff0000u); }
__device__ __forceinline__ unsigned cvtpk(float lo, float hi) { return pg8::cvt_pk_bf16(lo, hi); }
__device__ __forceinline__ float wave_sum(float v) {
#pragma unroll
    for (int o = 1; o < 64; o <<= 1) v += __shfl_xor(v, o);
    return v;
}
__device__ __forceinline__ v4i16_t ldtr(LAS const unsigned char* p) { return __builtin_amdgcn_ds_read_tr16_b64_v4i16((LAS v4i16_t*)p); }
__device__ __forceinline__ bf16x8 cat8(v4i16_t a, v4i16_t b) { return (bf16x8){a[0], a[1], a[2], a[3], b[0], b[1], b[2], b[3]}; }
__device__ __forceinline__ float gelu1(float x) { const pg8::f32x2 r = pg8::gelu_pk((pg8::f32x2){x, x}); return r.x; }
__device__ __forceinline__ float silu_mul(float g, float v) { return g * __builtin_amdgcn_rcpf(1.0f + __expf(-g)) * v; }

struct P0Seg { const float* W; bf16* WT; const float* g; float* cmax; int K, N, item; bool up, had; };
__device__ __forceinline__ void p0_load(const P0Seg& sg, int lane, f32x4 (&v)[16]) {
    const int nblk = sg.N >> 6, kb = sg.item / nblk, nb = sg.item - kb * nblk;
    const float* src = sg.W + (size_t)(64 * kb + (lane >> 4)) * sg.N + 64 * nb + 4 * (lane & 15);
#pragma unroll
    for (int j = 0; j < 16; ++j) v[j] = __builtin_nontemporal_load((const GAS f32x4*)(src + (size_t)(4 * j) * sg.N));
}
__device__ __forceinline__ void p0_store(const P0Seg& sg, int lane, f32x4 (&v)[16], LAS unsigned char* T) {
    if (sg.had) {
#pragma unroll
        for (int mask = 1; mask < 16; mask <<= 1)
#pragma unroll
            for (int j = 0; j < 16; ++j) if (!(j & mask)) { const f32x4 a = v[j], b = v[j | mask]; v[j] = a + b; v[j | mask] = a - b; }
#pragma unroll
        for (int sh = 16; sh <= 32; sh <<= 1)
#pragma unroll
            for (int j = 0; j < 16; ++j) { f32x4 p; p.x = __shfl_xor(v[j].x, sh); p.y = __shfl_xor(v[j].y, sh); p.z = __shfl_xor(v[j].z, sh); p.w = __shfl_xor(v[j].w, sh);
                const unsigned sm = (lane & sh) ? 0x80000000u : 0u;
                v[j].x = p.x + __uint_as_float(__float_as_uint(v[j].x) ^ sm); v[j].y = p.y + __uint_as_float(__float_as_uint(v[j].y) ^ sm); v[j].z = p.z + __uint_as_float(__float_as_uint(v[j].z) ^ sm); v[j].w = p.w + __uint_as_float(__float_as_uint(v[j].w) ^ sm); }
#pragma unroll
        for (int j = 0; j < 16; ++j) v[j] *= 0.125f;
    }
    const int nblk = sg.N >> 6, kb = sg.item / nblk, nb = sg.item - kb * nblk, k0 = 64 * kb, n0 = 64 * nb;
    const int r0 = !sg.up ? n0 : (n0 < DFF ? 256 * (n0 >> 7) + (n0 & 127) : 256 * ((n0 - DFF) >> 7) + 128 + ((n0 - DFF) & 127));
    float cm0 = 0.f, cm1 = 0.f, cm2 = 0.f, cm3 = 0.f;
#pragma unroll
    for (int j = 0; j < 16; ++j) { const float gk = sg.g ? sg.g[k0 + 4 * j + (lane >> 4)] : 1.0f; u32x2g w; w.x = cvtpk(v[j].x * gk, v[j].y * gk); w.y = cvtpk(v[j].z * gk, v[j].w * gk); *(LAS u32x2g*)(T + (4 * j + (lane >> 4)) * 144 + (lane & 15) * 8) = w;
        cm0 = fmaxf(cm0, fabsf(bflo(w.x))); cm1 = fmaxf(cm1, fabsf(bfhi(w.x))); cm2 = fmaxf(cm2, fabsf(bflo(w.y))); cm3 = fmaxf(cm3, fabsf(bfhi(w.y))); }
    if (sg.cmax) {
        cm0 = fmaxf(cm0, __shfl_xor(cm0, 16)); cm0 = fmaxf(cm0, __shfl_xor(cm0, 32)); cm1 = fmaxf(cm1, __shfl_xor(cm1, 16)); cm1 = fmaxf(cm1, __shfl_xor(cm1, 32));
        cm2 = fmaxf(cm2, __shfl_xor(cm2, 16)); cm2 = fmaxf(cm2, __shfl_xor(cm2, 32)); cm3 = fmaxf(cm3, __shfl_xor(cm3, 16)); cm3 = fmaxf(cm3, __shfl_xor(cm3, 32));
        if (lane < 16) { unsigned* cp = (unsigned*)(sg.cmax + r0 + 4 * lane); atomicMax(cp, __float_as_uint(cm0)); atomicMax(cp + 1, __float_as_uint(cm1)); atomicMax(cp + 2, __float_as_uint(cm2)); atomicMax(cp + 3, __float_as_uint(cm3)); } }
    asm volatile("s_waitcnt lgkmcnt(0)" ::: "memory");
    const int g = lane >> 4, i = lane & 15;
    bf16x8 o[8];
#pragma unroll
    for (int p = 0; p < 8; ++p) { const int kc = g + 4 * (p & 1), nbk = p >> 1;
        LAS const unsigned char* a = T + (8 * kc + (i >> 2)) * 144 + (16 * nbk + 4 * (i & 3)) * 2;
        o[p] = cat8(ldtr(a), ldtr(a + 4 * 144)); }
    asm volatile("s_waitcnt lgkmcnt(0)" ::: "memory");
#pragma unroll
    for (int p = 0; p < 8; ++p) { const int kc = g + 4 * (p & 1), nbk = p >> 1; *(LAS bf16x8*)(T + (16 * nbk + i) * 144 + 16 * kc) = o[p]; }
    asm volatile("s_waitcnt lgkmcnt(0)" ::: "memory");
#pragma unroll
    for (int q = 0; q < 8; ++q) { const int row = 8 * q + (lane >> 3), pc = lane & 7;
        const bf16x8 v8 = *(LAS const bf16x8*)(T + row * 144 + 16 * pc);
        *(GAS bf16x8*)(sg.WT + (size_t)(r0 + row) * sg.K + k0 + 8 * pc) = v8; }
    asm volatile("s_waitcnt lgkmcnt(0)" ::: "memory");
}

__device__ __forceinline__ unsigned q8x4(float a, float b, float c, float d, float inv) {
    const float M = 12582912.0f;
    const unsigned ua = __float_as_uint(fmaf(a, inv, M)), ub = __float_as_uint(fmaf(b, inv, M)), uc = __float_as_uint(fmaf(c, inv, M)), ud = __float_as_uint(fmaf(d, inv, M));
    return __builtin_amdgcn_perm(ub, ua, 0x0c0c0400u) | __builtin_amdgcn_perm(ud, uc, 0x04000c0cu);
}
__device__ __forceinline__ float wave_max(float v) {
#pragma unroll
    for (int o = 1; o < 64; o <<= 1) v = fmaxf(v, __shfl_xor(v, o));
    return v;
}
constexpr int ST_RED_OFF = 65536;
__device__ __forceinline__ void p0_strip_up(LAS unsigned char* lds, const float* W, const float* g, unsigned char* WQ, float* sw, int sidx, int par, int lane_in, int wave) {
    int lane = lane_in; asm volatile("" : "+v"(lane));
    const int n0 = 32 * sidx, cg = lane & 7, rg = lane >> 3, kw = 512 * wave;
    const int r0 = n0 < DFF ? 256 * (n0 >> 7) + (n0 & 127) : 256 * ((n0 - DFF) >> 7) + 128 + ((n0 - DFF) & 127);
    unsigned P[16][4][2];
    const float* srcu = W + (size_t)kw * DFF2 + n0; const int lo = 4 * rg * DFF2 + 4 * cg;
    float m0 = 0.f, m1 = 0.f, m2 = 0.f, m3 = 0.f;
#pragma unroll
    for (int jb = 0; jb < 4; ++jb) { f32x4 v[4][4], gk[4];
#pragma unroll
        for (int jj = 0; jj < 4; ++jj) { gk[jj] = *(const GAS f32x4*)(g + kw + 32 * (4 * jb + jj) + 4 * rg);
#pragma unroll
            for (int i = 0; i < 4; ++i) v[jj][i] = __builtin_nontemporal_load((const GAS f32x4*)((srcu + (size_t)(32 * (4 * jb + jj) + i) * DFF2) + lo)); }
#pragma unroll
        for (int jj = 0; jj < 4; ++jj)
#pragma unroll
            for (int i = 0; i < 4; ++i) { const float gg = gk[jj][i]; const unsigned a = cvtpk(v[jj][i].x * gg, v[jj][i].y * gg), b = cvtpk(v[jj][i].z * gg, v[jj][i].w * gg);
                P[4 * jb + jj][i][0] = a; P[4 * jb + jj][i][1] = b;
                m0 = fmaxf(m0, fabsf(bflo(a))); m1 = fmaxf(m1, fabsf(bfhi(a))); m2 = fmaxf(m2, fabsf(bflo(b))); m3 = fmaxf(m3, fabsf(bfhi(b))); }
        asm volatile("" ::: "memory");
    }
#pragma unroll
    for (int sh = 8; sh < 64; sh <<= 1) { m0 = fmaxf(m0, __shfl_xor(m0, sh)); m1 = fmaxf(m1, __shfl_xor(m1, sh)); m2 = fmaxf(m2, __shfl_xor(m2, sh)); m3 = fmaxf(m3, __shfl_xor(m3, sh)); }
    LAS float* red = (LAS float*)(lds + ST_RED_OFF) + par * 256;
    asm volatile("" : "+v"(lane)); const int cg2 = lane & 7, rg2 = lane >> 3;
#pragma unroll
    for (int j = 0; j < 16; ++j)
#pragma unroll
        for (int i = 0; i < 4; ++i) asm volatile("" : "+v"(P[j][i][0]), "+v"(P[j][i][1]));
    if (rg2 == 0) *(LAS f32x4*)(red + wave * 32 + 4 * cg2) = (f32x4){m0, m1, m2, m3};
    __syncthreads();
    f32x4 cm = *(LAS const f32x4*)(red + 4 * cg2);
#pragma unroll
    for (int w = 1; w < 8; ++w) { const f32x4 o = *(LAS const f32x4*)(red + w * 32 + 4 * cg2); cm.x = fmaxf(cm.x, o.x); cm.y = fmaxf(cm.y, o.y); cm.z = fmaxf(cm.z, o.z); cm.w = fmaxf(cm.w, o.w); }
    const float i0 = cm.x > 0.f ? 127.0f / cm.x : 0.f, i1 = cm.y > 0.f ? 127.0f / cm.y : 0.f, i2 = cm.z > 0.f ? 127.0f / cm.z : 0.f, i3 = cm.w > 0.f ? 127.0f / cm.w : 0.f;
    if (wave == 0 && rg2 == 0) *(GAS f32x4*)(sw + r0 + 4 * cg2) = cm * (1.0f / 127.0f);
    LAS unsigned char* T = lds + wave * 8192;
#pragma unroll
    for (int jh = 0; jh < 2; ++jh) {
#pragma unroll
        for (int jp = 0; jp < 8; ++jp) { const int j = 8 * jh + jp, d = (8 * jp + rg2) ^ (cg2 << 2);
            LAS unsigned* tp = (LAS unsigned*)(T + (4 * cg2) * 256 + 4 * d);
            tp[0] = q8x4(bflo(P[j][0][0]), bflo(P[j][1][0]), bflo(P[j][2][0]), bflo(P[j][3][0]), i0);
            tp[64] = q8x4(bfhi(P[j][0][0]), bfhi(P[j][1][0]), bfhi(P[j][2][0]), bfhi(P[j][3][0]), i1);
            tp[128] = q8x4(bflo(P[j][0][1]), bflo(P[j][1][1]), bflo(P[j][2][1]), bflo(P[j][3][1]), i2);
            tp[192] = q8x4(bfhi(P[j][0][1]), bfhi(P[j][1][1]), bfhi(P[j][2][1]), bfhi(P[j][3][1]), i3); }
        asm volatile("s_waitcnt lgkmcnt(0)" ::: "memory");
#pragma unroll
        for (int t = 0; t < 8; ++t) { const int id = lane + 64 * t, row = id >> 4, Q = id & 15;
            const v4u val = *(LAS const v4u*)(T + row * 256 + 16 * (Q ^ (row >> 2)));
            *(GAS v4u*)(WQ + (size_t)(r0 + row) * D + kw + 256 * jh + 16 * Q) = val; }
        asm volatile("s_waitcnt lgkmcnt(0)" ::: "memory");
    }
}
__device__ __forceinline__ void ld8(const float* row, int chunk, float (&o)[8]) { const f32x4 a = *(const GAS f32x4*)(row + 8 * chunk), b = *(const GAS f32x4*)(row + 8 * chunk + 4);
    o[0] = a.x; o[1] = a.y; o[2] = a.z; o[3] = a.w; o[4] = b.x; o[5] = b.y; o[6] = b.z; o[7] = b.w; }
__device__ __forceinline__ void up8(const v4u x, float (&o)[8]) { o[0] = bflo(x.x); o[1] = bfhi(x.x); o[2] = bflo(x.y); o[3] = bfhi(x.y); o[4] = bflo(x.z); o[5] = bfhi(x.z); o[6] = bflo(x.w); o[7] = bfhi(x.w); }
__device__ __forceinline__ void ld8(const bf16* row, int chunk, float (&o)[8]) { up8(*(const GAS v4u*)(row + 8 * chunk), o); }
__device__ __forceinline__ void st8(float* row, int chunk, const float (&v)[8]) { *(GAS f32x4*)(row + 8 * chunk) = (f32x4){v[0], v[1], v[2], v[3]}; *(GAS f32x4*)(row + 8 * chunk + 4) = (f32x4){v[4], v[5], v[6], v[7]}; }
__device__ __forceinline__ void st8(bf16* row, int chunk, const float (&v)[8]) { v4u w; w.x = cvtpk(v[0], v[1]); w.y = cvtpk(v[2], v[3]); w.z = cvtpk(v[4], v[5]); w.w = cvtpk(v[6], v[7]); *(GAS v4u*)(row + 8 * chunk) = w; }
template <bool NORMED> __device__ __forceinline__ void first_row(const float* xrow, bf16* xb, float* r2, int lane, unsigned char* xq = nullptr, float* rq = nullptr) {
    float v[8][8]; float ss = 0.f;
#pragma unroll
    for (int j = 0; j < 8; ++j) { ld8(xrow, lane + 64 * j, v[j]);
#pragma unroll
        for (int e = 0; e < 8; ++e) ss += v[j][e] * v[j][e]; }
    const float r = 1.0f / sqrtf(wave_sum(ss) * (1.0f / D) + NORM_EPS);
    if (!NORMED && lane == 0) *r2 = r;
    if (xq) { float mx = 0.f;
#pragma unroll
        for (int j = 0; j < 8; ++j)
#pragma unroll
            for (int e = 0; e < 8; ++e) mx = fmaxf(mx, fabsf(__uint_as_float(f2bf(v[j][e]) << 16)));
        mx = wave_max(mx); const float inv = mx > 0.f ? 127.0f / mx : 0.f; if (lane == 0) *rq = r * mx * (1.0f / 127.0f);
#pragma unroll
        for (int j = 0; j < 8; ++j) { float t[8];
#pragma unroll
            for (int e = 0; e < 8; ++e) t[e] = __uint_as_float(f2bf(v[j][e]) << 16);
            u32x2g q; q.x = q8x4(t[0], t[1], t[2], t[3], inv); q.y = q8x4(t[4], t[5], t[6], t[7], inv); *(GAS u32x2g*)(xq + 8 * (lane + 64 * j)) = q; } }
#pragma unroll
    for (int j = 0; j < 8; ++j) { if (NORMED) {
#pragma unroll
            for (int e = 0; e < 8; ++e) v[j][e] *= r; }
        st8(xb, lane + 64 * j, v[j]); }
}
template <typename TY, typename TXI, typename TXO>
__device__ __forceinline__ void resid_norm_row(const TY* yrow, const TXI* xin, const float* gpost, TXO* xout, float* r2, bf16* hn, int lane, unsigned char* hq = nullptr, float* hs = nullptr) {
    float v[8][8]; float ss = 0.f;
#pragma unroll
    for (int j = 0; j < 8; ++j) { ld8(yrow, lane + 64 * j, v[j]);
#pragma unroll
        for (int e = 0; e < 8; ++e) ss += v[j][e] * v[j][e]; }
    const float r = 1.0f / sqrtf(wave_sum(ss) * (1.0f / D) + NORM_EPS);
    float s2 = 0.f;
#pragma unroll
    for (int j = 0; j < 8; ++j) { float xx[8], gg[8]; ld8(xin, lane + 64 * j, xx); ld8(gpost, lane + 64 * j, gg);
#pragma unroll
        for (int e = 0; e < 8; ++e) { v[j][e] = xx[e] + v[j][e] * r * gg[e]; s2 += v[j][e] * v[j][e]; }
        st8(xout, lane + 64 * j, v[j]); }
    if (r2 || hn) {
        const float rr = 1.0f / sqrtf(wave_sum(s2) * (1.0f / D) + NORM_EPS);
        if (r2 && lane == 0) *r2 = rr;
        if (hn) {
#pragma unroll
            for (int j = 0; j < 8; ++j) { float o[8];
#pragma unroll
                for (int e = 0; e < 8; ++e) o[e] = v[j][e] * rr;
                st8(hn, lane + 64 * j, o); }
            if (hq) { float mx = 0.f;
#pragma unroll
                for (int j = 0; j < 8; ++j)
#pragma unroll
                    for (int e = 0; e < 8; ++e) mx = fmaxf(mx, fabsf(__uint_as_float(f2bf(v[j][e] * rr) << 16)));
                mx = wave_max(mx); const float inv = mx > 0.f ? 127.0f / mx : 0.f; if (lane == 0) *hs = mx * (1.0f / 127.0f);
#pragma unroll
                for (int j = 0; j < 8; ++j) { float t[8];
#pragma unroll
                    for (int e = 0; e < 8; ++e) t[e] = __uint_as_float(f2bf(v[j][e] * rr) << 16);
                    u32x2g q; q.x = q8x4(t[0], t[1], t[2], t[3], inv); q.y = q8x4(t[4], t[5], t[6], t[7], inv); *(GAS u32x2g*)(hq + 8 * (lane + 64 * j)) = q; } } }
    }
}
template <typename TXO, bool QUANT = false> __device__ __forceinline__ void resid_norm_row2(const bf16* ya, const bf16* yb, const bf16* xia, const bf16* xib, TXO* xa, TXO* xb, const float* gpost, float* r2a, float* r2b, int lane,
                                                                                            unsigned char* xqa = nullptr, unsigned char* xqb = nullptr, float* rqa = nullptr, float* rqb = nullptr, unsigned char* cqa = nullptr, unsigned char* cqb = nullptr, float* csa = nullptr, float* csb = nullptr) {
#define CH2(j) (QUANT ? 2 * lane + ((j) & 1) + 128 * ((j) >> 1) : lane + 64 * (j))
    v4u yra[8], yrb[8], xra[8], xrb[8];
#pragma unroll
    for (int j = 0; j < 8; ++j) { yra[j] = *(const GAS v4u*)(ya + 8 * (CH2(j))); yrb[j] = *(const GAS v4u*)(yb + 8 * (CH2(j))); }
#pragma unroll
    for (int j = 0; j < 8; ++j) { xra[j] = *(const GAS v4u*)(xia + 8 * (CH2(j))); xrb[j] = *(const GAS v4u*)(xib + 8 * (CH2(j))); }
    float sa = 0.f, sb = 0.f;
#pragma unroll
    for (int j = 0; j < 8; ++j) { float t[8]; up8(yra[j], t);
#pragma unroll
        for (int e = 0; e < 8; ++e) sa += t[e] * t[e];
        up8(yrb[j], t);
#pragma unroll
        for (int e = 0; e < 8; ++e) sb += t[e] * t[e]; }
    const float ra = 1.0f / sqrtf(wave_sum(sa) * (1.0f / D) + NORM_EPS), rb = 1.0f / sqrtf(wave_sum(sb) * (1.0f / D) + NORM_EPS);
#pragma unroll
    for (int j = 0; j < 8; ++j) asm volatile("" : "+v"(yra[j]), "+v"(yrb[j]));
    float qa = 0.f, qb = 0.f;
#pragma unroll
    for (int j = 0; j < 8; ++j) { float gg[8], y[8], x[8], o[8]; ld8(gpost, CH2(j), gg);
        up8(yra[j], y); up8(xra[j], x);
#pragma unroll
        for (int e = 0; e < 8; ++e) { o[e] = x[e] + y[e] * ra * gg[e]; qa += o[e] * o[e]; }
        st8(xa, CH2(j), o); if (QUANT) { xra[j].x = cvtpk(o[0], o[1]); xra[j].y = cvtpk(o[2], o[3]); xra[j].z = cvtpk(o[4], o[5]); xra[j].w = cvtpk(o[6], o[7]); }
        up8(yrb[j], y); up8(xrb[j], x);
#pragma unroll
        for (int e = 0; e < 8; ++e) { o[e] = x[e] + y[e] * rb * gg[e]; qb += o[e] * o[e]; }
        st8(xb, CH2(j), o); if (QUANT) { xrb[j].x = cvtpk(o[0], o[1]); xrb[j].y = cvtpk(o[2], o[3]); xrb[j].z = cvtpk(o[4], o[5]); xrb[j].w = cvtpk(o[6], o[7]); } }
    if (r2a) { const float r2av = 1.0f / sqrtf(wave_sum(qa) * (1.0f / D) + NORM_EPS), r2bv = 1.0f / sqrtf(wave_sum(qb) * (1.0f / D) + NORM_EPS);
        if (lane == 0) { *r2a = r2av; *r2b = r2bv; }
        if (QUANT) { float ma = 0.f, mb = 0.f;
#pragma unroll
            for (int j = 0; j < 8; ++j) { float t[8]; up8(xra[j], t);
#pragma unroll
                for (int e = 0; e < 8; ++e) ma = fmaxf(ma, fabsf(t[e]));
                up8(xrb[j], t);
#pragma unroll
                for (int e = 0; e < 8; ++e) mb = fmaxf(mb, fabsf(t[e])); }
            ma = wave_max(ma); mb = wave_max(mb);
            const float ia = ma > 0.f ? 127.0f / ma : 0.f, ib = mb > 0.f ? 127.0f / mb : 0.f;
            if (lane == 0) { *rqa = r2av * ma * (1.0f / 127.0f); *rqb = r2bv * mb * (1.0f / 127.0f); if (cqa) *csa = r2av * ma * (1.0f / 127.0f); if (cqb) *csb = r2bv * mb * (1.0f / 127.0f); }
#pragma unroll
            for (int jj = 0; jj < 4; ++jj) { v4u qa4, qb4;
#pragma unroll
                for (int h = 0; h < 2; ++h) { const int j = 2 * jj + h; float t[8]; up8(xra[j], t);
                    if (h == 0) { qa4.x = q8x4(t[0], t[1], t[2], t[3], ia); qa4.y = q8x4(t[4], t[5], t[6], t[7], ia); } else { qa4.z = q8x4(t[0], t[1], t[2], t[3], ia); qa4.w = q8x4(t[4], t[5], t[6], t[7], ia); }
                    up8(xrb[j], t);
                    if (h == 0) { qb4.x = q8x4(t[0], t[1], t[2], t[3], ib); qb4.y = q8x4(t[4], t[5], t[6], t[7], ib); } else { qb4.z = q8x4(t[0], t[1], t[2], t[3], ib); qb4.w = q8x4(t[4], t[5], t[6], t[7], ib); }
                    }
                *(GAS v4u*)(xqa + 8 * CH2(2 * jj)) = qa4; *(GAS v4u*)(xqb + 8 * CH2(2 * jj)) = qb4;
                if (cqa) *(GAS v4u*)(cqa + 8 * CH2(2 * jj)) = qa4; if (cqb) *(GAS v4u*)(cqb + 8 * CH2(2 * jj)) = qb4; } }
    }
}
#undef CH2
__device__ __forceinline__ void final_row2(const bf16* ya, const bf16* yb, const bf16* xia, const bf16* xib, float* oa, float* ob, const float* gpost, int lane) {
    u32x2g yra[16], yrb[16], xra[16], xrb[16];
#pragma unroll
    for (int j = 0; j < 16; ++j) { const int e = 4 * (lane + 64 * j); yra[j] = *(const GAS u32x2g*)(ya + e); yrb[j] = *(const GAS u32x2g*)(yb + e); }
#pragma unroll
    for (int j = 0; j < 16; ++j) { const int e = 4 * (lane + 64 * j); xra[j] = *(const GAS u32x2g*)(xia + e); xrb[j] = *(const GAS u32x2g*)(xib + e); }
    float sa = 0.f, sb = 0.f;
#pragma unroll
    for (int j = 0; j < 16; ++j) { const float a0 = bflo(yra[j].x), a1 = bfhi(yra[j].x), a2 = bflo(yra[j].y), a3 = bfhi(yra[j].y); sa += (a0 * a0 + a1 * a1) + (a2 * a2 + a3 * a3);
        const float b0 = bflo(yrb[j].x), b1 = bfhi(yrb[j].x), b2 = bflo(yrb[j].y), b3 = bfhi(yrb[j].y); sb += (b0 * b0 + b1 * b1) + (b2 * b2 + b3 * b3); }
    const float ra = 1.0f / sqrtf(wave_sum(sa) * (1.0f / D) + NORM_EPS), rb = 1.0f / sqrtf(wave_sum(sb) * (1.0f / D) + NORM_EPS);
#pragma unroll
    for (int j = 0; j < 16; ++j) asm volatile("" : "+v"(yra[j]), "+v"(yrb[j]));
#pragma unroll
    for (int j = 0; j < 16; ++j) { const int e = 4 * (lane + 64 * j); const f32x4 gg = *(const GAS f32x4*)(gpost + e);
        f32x4 o; o.x = bflo(xra[j].x) + bflo(yra[j].x) * ra * gg.x; o.y = bfhi(xra[j].x) + bfhi(yra[j].x) * ra * gg.y; o.z = bflo(xra[j].y) + bflo(yra[j].y) * ra * gg.z; o.w = bfhi(xra[j].y) + bfhi(yra[j].y) * ra * gg.w;
        *(GAS f32x4*)(oa + e) = o;
        o.x = bflo(xrb[j].x) + bflo(yrb[j].x) * rb * gg.x; o.y = bfhi(xrb[j].x) + bfhi(yrb[j].x) * rb * gg.y; o.z = bflo(xrb[j].y) + bflo(yrb[j].y) * rb * gg.z; o.w = bfhi(xrb[j].y) + bfhi(yrb[j].y) * rb * gg.w;
        *(GAS f32x4*)(ob + e) = o; }
}

__device__ __forceinline__ float dpp_quad_x1(float x) { return __int_as_float(__builtin_amdgcn_update_dpp(0, __float_as_int(x), 0xB1, 0xf, 0xf, true)); }
__device__ __forceinline__ float dpp_quad_x2(float x) { return __int_as_float(__builtin_amdgcn_update_dpp(0, __float_as_int(x), 0x4E, 0xf, 0xf, true)); }
__device__ __forceinline__ void act_row_load(v4u (&x)[11][2], const bf16* arow, int lane) {
#pragma unroll
    for (int i = 0; i < 11; ++i) { const int c = lane + 64 * i;
        if (i < 10 || lane < 48) { x[i][0] = *(const GAS v4u*)(arow + 16 * c); x[i][1] = *(const GAS v4u*)(arow + 16 * c + 8); } else { x[i][0] = (v4u){0u, 0u, 0u, 0u}; x[i][1] = (v4u){0u, 0u, 0u, 0u}; } }
}
template <bool QUANT> __device__ __forceinline__ void act_row_proc(v4u (&x)[11][2], unsigned char* qrow, float* sa, bf16* orow, int lane);
template <bool QUANT> __device__ __forceinline__ void act_rot_row(const bf16* arow, unsigned char* qrow, float* sa, bf16* orow, int lane) { v4u x[11][2]; act_row_load(x, arow, lane); act_row_proc<QUANT>(x, qrow, sa, orow, lane); }
__device__ __forceinline__ void act_rot_rows(const bf16* ACT, unsigned char* ACTQ, float* SA, int r0, int r_end, int stride, int lane) {
    if (r0 >= r_end) return;
    v4u xa[11][2], xb[11][2]; act_row_load(xa, ACT + (size_t)r0 * DFF, lane);
    for (int r = r0; r < r_end; r += 2 * stride) { const int r1 = r + stride, r2 = r + 2 * stride;
        if (r1 < r_end) act_row_load(xb, ACT + (size_t)r1 * DFF, lane);
        act_row_proc<true>(xa, ACTQ + (size_t)r * DFF, SA + r, (bf16*)nullptr, lane);
        if (r2 < r_end) act_row_load(xa, ACT + (size_t)r2 * DFF, lane);
        if (r1 < r_end) act_row_proc<true>(xb, ACTQ + (size_t)r1 * DFF, SA + r1, (bf16*)nullptr, lane); }
}
template <bool QUANT> __device__ __forceinline__ void act_row_proc(v4u (&x)[11][2], unsigned char* qrow, float* sa, bf16* orow, int lane) {
    float mx = 0.f; const unsigned sm1 = (unsigned)(lane & 1) << 31, sm2 = (unsigned)(lane & 2) << 30;
#pragma unroll
    for (int i = 0; i < 11; ++i) { float t[16];
        { float a[8]; up8(x[i][0], a);
#pragma unroll
          for (int e = 0; e < 8; ++e) t[e] = a[e];
          up8(x[i][1], a);
#pragma unroll
          for (int e = 0; e < 8; ++e) t[8 + e] = a[e]; }
#pragma unroll
        for (int mask = 1; mask < 16; mask <<= 1)
#pragma unroll
            for (int e = 0; e < 16; ++e) if (!(e & mask)) { const float a = t[e], b = t[e | mask]; t[e] = a + b; t[e | mask] = a - b; }
#pragma unroll
        for (int e = 0; e < 16; ++e) t[e] = dpp_quad_x1(t[e]) + __uint_as_float(__float_as_uint(t[e]) ^ sm1);
#pragma unroll
        for (int e = 0; e < 16; ++e) t[e] = dpp_quad_x2(t[e]) + __uint_as_float(__float_as_uint(t[e]) ^ sm2);
        if (QUANT) {
#pragma unroll
            for (int e = 0; e < 16; e += 2) mx = fmaxf(mx, fmaxf(fabsf(t[e]), fabsf(t[e + 1])));
        } else {
#pragma unroll
            for (int e = 0; e < 16; ++e) t[e] *= 0.125f; }
        x[i][0].x = cvtpk(t[0], t[1]); x[i][0].y = cvtpk(t[2], t[3]); x[i][0].z = cvtpk(t[4], t[5]); x[i][0].w = cvtpk(t[6], t[7]);
        x[i][1].x = cvtpk(t[8], t[9]); x[i][1].y = cvtpk(t[10], t[11]); x[i][1].z = cvtpk(t[12], t[13]); x[i][1].w = cvtpk(t[14], t[15]);
        if (!QUANT && (i < 10 || lane < 48)) { const int c = lane + 64 * i; *(GAS v4u*)(orow + 16 * c) = x[i][0]; *(GAS v4u*)(orow + 16 * c + 8) = x[i][1]; } }
    if (QUANT) { mx = wave_max(mx); const float inv = mx > 0.f ? 127.0f / mx : 0.f; if (lane == 0) *sa = mx * (0.125f / 127.0f);
#pragma unroll
        for (int i = 0; i < 11; ++i) { float a[8], b[8]; up8(x[i][0], a); up8(x[i][1], b); v4u q;
            q.x = q8x4(a[0], a[1], a[2], a[3], inv); q.y = q8x4(a[4], a[5], a[6], a[7], inv); q.z = q8x4(b[0], b[1], b[2], b[3], inv); q.w = q8x4(b[4], b[5], b[6], b[7], inv);
            if (i < 10 || lane < 48) *(GAS v4u*)(qrow + 16 * (lane + 64 * i)) = q; } }
}
template <int NT, int RT, class RowOf, class Epi> __device__ __forceinline__ void skinny_gemm(LAS unsigned char* lds, const bf16* A, const bf16* Bt, int K, int t_begin, int t_end, int t_stride,
                                                                                      const RowOf& rowof, const Epi& epi, int tid, int wave, int lane) {
    constexpr int CT = NT / 16, NR = 16 * RT;
    const int fr = lane & 15, fq = lane >> 4, kw = K / 8, k0 = wave * kw;
    LAS float* red = (LAS float*)lds; LAS float* sums = red + 8 * NR * NT;
    for (int tile = t_begin; tile < t_end; tile += t_stride) {
        f32x4 acc[RT][CT];
#pragma unroll
        for (int r = 0; r < RT; ++r)
#pragma unroll
            for (int c = 0; c < CT; ++c) acc[r][c] = (f32x4){0.f, 0.f, 0.f, 0.f};
        const bf16* ap = A + (size_t)fr * K + k0 + 8 * fq; const bf16* bp[CT];
#pragma unroll
        for (int c = 0; c < CT; ++c) bp[c] = Bt + (size_t)(rowof(tile, c) + fr) * K + k0 + 8 * fq;
#pragma unroll 8
        for (int k = 0; k < kw; k += 32) {
            bf16x8 a[RT];
#pragma unroll
            for (int r = 0; r < RT; ++r) a[r] = *(const GAS bf16x8*)(ap + (size_t)(16 * r) * K + k);
#pragma unroll
            for (int c = 0; c < CT; ++c) { const bf16x8 b = *(const GAS bf16x8*)(bp[c] + k);
#pragma unroll
                for (int r = 0; r < RT; ++r) acc[r][c] = __builtin_amdgcn_mfma_f32_16x16x32_bf16(a[r], b, acc[r][c], 0, 0, 0); }
        }
#pragma unroll
        for (int r = 0; r < RT; ++r)
#pragma unroll
            for (int c = 0; c < CT; ++c)
#pragma unroll
                for (int i = 0; i < 4; ++i) red[(wave * NR + 16 * r + 4 * fq + i) * NT + 16 * c + fr] = acc[r][c][i];
        __syncthreads();
        for (int e = tid; e < NR * NT; e += NWAVES * 64) { float sm = 0.f;
#pragma unroll
            for (int w = 0; w < 8; ++w) sm += red[w * NR * NT + e];
            sums[e] = sm; }
        __syncthreads();
        for (int t = tid; t < NR * NT; t += NWAVES * 64) epi(tile, t, sums);
    }
}
__device__ __forceinline__ bf16x8 i8x8_to_bf16(unsigned lo, unsigned hi) {
    v4u w; w.x = cvtpk((float)(signed char)(lo), (float)(signed char)(lo >> 8)); w.y = cvtpk((float)(signed char)(lo >> 16), (float)((int)lo >> 24));
    w.z = cvtpk((float)(signed char)(hi), (float)(signed char)(hi >> 8)); w.w = cvtpk((float)(signed char)(hi >> 16), (float)((int)hi >> 24));
    return __builtin_bit_cast(bf16x8, w);
}
template <int NT, int RT, class RowOf, class Epi> __device__ __forceinline__ void skinny_gemm_w8(LAS unsigned char* lds, const bf16* A, const unsigned char* Bq, int K, int t_begin, int t_end, int t_stride,
                                                                                         const RowOf& rowof, const Epi& epi, int tid, int wave, int lane) {
    constexpr int CT = NT / 16, NR = 16 * RT;
    const int fr = lane & 15, fq = lane >> 4, nblk = K >> 6, base = nblk >> 3, rem = nblk & 7, nb = base + (wave < rem ? 1 : 0), k0 = 64 * (wave * base + (wave < rem ? wave : rem));
    LAS float* red = (LAS float*)lds; LAS float* sums = red + 8 * NR * NT;
    for (int tile = t_begin; tile < t_end; tile += t_stride) {
        f32x4 acc[RT][CT];
#pragma unroll
        for (int r = 0; r < RT; ++r)
#pragma unroll
            for (int c = 0; c < CT; ++c) acc[r][c] = (f32x4){0.f, 0.f, 0.f, 0.f};
        const bf16* ap = A + (size_t)fr * K + k0 + 16 * fq; const unsigned char* bp[CT];
#pragma unroll
        for (int c = 0; c < CT; ++c) bp[c] = Bq + (size_t)(rowof(tile, c) + fr) * K + k0 + 16 * fq;
#pragma unroll 4
        for (int s = 0; s < nb; ++s) { const int k = 64 * s;
            bf16x8 a[RT][2];
#pragma unroll
            for (int r = 0; r < RT; ++r) { a[r][0] = *(const GAS bf16x8*)(ap + (size_t)(16 * r) * K + k); a[r][1] = *(const GAS bf16x8*)(ap + (size_t)(16 * r) * K + k + 8); }
#pragma unroll
            for (int c = 0; c < CT; ++c) { const v4u w = *(const GAS v4u*)(bp[c] + k); const bf16x8 b0 = i8x8_to_bf16(w.x, w.y), b1 = i8x8_to_bf16(w.z, w.w);
#pragma unroll
                for (int r = 0; r < RT; ++r) { acc[r][c] = __builtin_amdgcn_mfma_f32_16x16x32_bf16(a[r][0], b0, acc[r][c], 0, 0, 0); acc[r][c] = __builtin_amdgcn_mfma_f32_16x16x32_bf16(a[r][1], b1, acc[r][c], 0, 0, 0); } }
        }
#pragma unroll
        for (int r = 0; r < RT; ++r)
#pragma unroll
            for (int c = 0; c < CT; ++c)
#pragma unroll
                for (int i = 0; i < 4; ++i) red[(wave * NR + 16 * r + 4 * fq + i) * NT + 16 * c + fr] = acc[r][c][i];
        __syncthreads();
        for (int e = tid; e < NR * NT; e += NWAVES * 64) { float sm = 0.f;
#pragma unroll
            for (int w = 0; w < 8; ++w) sm += red[w * NR * NT + e];
            sums[e] = sm; }
        __syncthreads();
        for (int t = tid; t < NR * NT; t += NWAVES * 64) epi(tile, t, sums);
    }
}
template <int NT> __device__ __forceinline__ void skinny_plain_w8(LAS unsigned char* lds, const bf16* A, const unsigned char* Bq, int K, float* out, int ldo, const float* scale,
                                                                  int t_begin, int t_end, int t_stride, int tid, int wave, int lane) {
    auto rowof = [](int tile, int c) { return tile * NT + 16 * c; };
    auto epi = [=](int tile, int t, LAS const float* sums) { const int row = t / NT, col = tile * NT + t % NT; out[(size_t)row * ldo + col] = sums[t] * scale[col]; };
    skinny_gemm_w8<NT, 2>(lds, A, Bq, K, t_begin, t_end, t_stride, rowof, epi, tid, wave, lane);
}
typedef int v4i32_t __attribute__((ext_vector_type(4)));
template <int NT, int RT, class RowOf, class Epi> __device__ __forceinline__ void skinny_i8_resident(LAS unsigned char* lds, const unsigned char* Aq, const unsigned char* Bq, int t_begin, int t_end, int t_stride,
                                                                                             const RowOf& rowof, const Epi& epi, int tid, int wave, int lane) {
    constexpr int CT = NT / 16, NR = 16 * RT, K = 4096;
    const int fr = lane & 15, fq = lane >> 4, k0 = 512 * wave + 16 * fq;
    LAS float* red = (LAS float*)lds; LAS float* sums = red + 8 * NR * NT;
    if (t_begin >= t_end) return;
    v4i32_t a[RT][8], b[CT][8];
#pragma unroll
    for (int r = 0; r < RT; ++r)
#pragma unroll
        for (int k = 0; k < 8; ++k) a[r][k] = *(const GAS v4i32_t*)(Aq + (size_t)(16 * r + fr) * K + k0 + 64 * k);
#pragma unroll
    for (int c = 0; c < CT; ++c)
#pragma unroll
        for (int k = 0; k < 8; ++k) b[c][k] = *(const GAS v4i32_t*)(Bq + (size_t)(rowof(t_begin, c) + fr) * K + k0 + 64 * k);
    for (int tile = t_begin; tile < t_end; tile += t_stride) {
        v4i32_t acc[RT][CT];
#pragma unroll
        for (int r = 0; r < RT; ++r)
#pragma unroll
            for (int c = 0; c < CT; ++c) acc[r][c] = (v4i32_t){0, 0, 0, 0};
#pragma unroll
        for (int k = 0; k < 8; ++k)
#pragma unroll
            for (int c = 0; c < CT; ++c)
#pragma unroll
                for (int r = 0; r < RT; ++r) acc[r][c] = __builtin_amdgcn_mfma_i32_16x16x64_i8(a[r][k], b[c][k], acc[r][c], 0, 0, 0);
        const int nxt = tile + t_stride;
        if (nxt < t_end) {
#pragma unroll
            for (int c = 0; c < CT; ++c)
#pragma unroll
                for (int k = 0; k < 8; ++k) b[c][k] = *(const GAS v4i32_t*)(Bq + (size_t)(rowof(nxt, c) + fr) * K + k0 + 64 * k); }
#pragma unroll
        for (int r = 0; r < RT; ++r)
#pragma unroll
            for (int c = 0; c < CT; ++c)
#pragma unroll
                for (int i = 0; i < 4; ++i) red[(wave * NR + 16 * r + 4 * fq + i) * NT + 16 * c + fr] = (float)acc[r][c][i];
        __syncthreads();
        for (int e = tid; e < NR * NT; e += NWAVES * 64) { float sm = 0.f;
#pragma unroll
            for (int w = 0; w < 8; ++w) sm += red[w * NR * NT + e];
            sums[e] = sm; }
        __syncthreads();
        for (int t = tid; t < NR * NT; t += NWAVES * 64) epi(tile, t, sums);
    }
}
template <int NT, int RT, class RowOf, class Epi> __device__ __forceinline__ void skinny_i8(LAS unsigned char* lds, const unsigned char* Aq, const unsigned char* Bq, int K, int t_begin, int t_end, int t_stride,
                                                                                     const RowOf& rowof, const Epi& epi, int tid, int wave, int lane) {
    constexpr int CT = NT / 16, NR = 16 * RT;
    const int fr = lane & 15, fq = lane >> 4, nblk = K >> 6, base = nblk >> 3, rem = nblk & 7, nb = base + (wave < rem ? 1 : 0), k0 = 64 * (wave * base + (wave < rem ? wave : rem)) + 16 * fq;
    LAS float* red = (LAS float*)lds; LAS float* sums = red + 8 * NR * NT;
    for (int tile = t_begin; tile < t_end; tile += t_stride) {
        v4i32_t acc[RT][CT];
#pragma unroll
        for (int r = 0; r < RT; ++r)
#pragma unroll
            for (int c = 0; c < CT; ++c) acc[r][c] = (v4i32_t){0, 0, 0, 0};
        const unsigned char* ap = Aq + (size_t)fr * K + k0; const unsigned char* bp[CT];
#pragma unroll
        for (int c = 0; c < CT; ++c) bp[c] = Bq + (size_t)(rowof(tile, c) + fr) * K + k0;
#pragma unroll 8
        for (int s = 0; s < nb; ++s) { v4i32_t a[RT];
#pragma unroll
            for (int r = 0; r < RT; ++r) a[r] = *(const GAS v4i32_t*)(ap + (size_t)(16 * r) * K + 64 * s);
#pragma unroll
            for (int c = 0; c < CT; ++c) { const v4i32_t b = *(const GAS v4i32_t*)(bp[c] + 64 * s);
#pragma unroll
                for (int r = 0; r < RT; ++r) acc[r][c] = __builtin_amdgcn_mfma_i32_16x16x64_i8(a[r], b, acc[r][c], 0, 0, 0); } }
#pragma unroll
        for (int r = 0; r < RT; ++r)
#pragma unroll
            for (int c = 0; c < CT; ++c)
#pragma unroll
                for (int i = 0; i < 4; ++i) red[(wave * NR + 16 * r + 4 * fq + i) * NT + 16 * c + fr] = (float)acc[r][c][i];
        __syncthreads();
        for (int e = tid; e < NR * NT; e += NWAVES * 64) { float sm = 0.f;
#pragma unroll
            for (int w = 0; w < 8; ++w) sm += red[w * NR * NT + e];
            sums[e] = sm; }
        __syncthreads();
        for (int t = tid; t < NR * NT; t += NWAVES * 64) epi(tile, t, sums);
    }
}
template <int NT, int ACT> __device__ __forceinline__ void skinny_plain(LAS unsigned char* lds, const bf16* A, const bf16* Bt, int N, int K, float* out, int ldo, const float* bias,
                                                                        int t_begin, int t_end, int t_stride, int tid, int wave, int lane) {
    auto rowof = [](int tile, int c) { return tile * NT + 16 * c; };
    auto epi = [=](int tile, int t, LAS const float* sums) { const int row = t / NT, col = tile * NT + t % NT; float v = sums[t]; if (bias) v += bias[col]; if (ACT == 1) v = gelu1(v); out[(size_t)row * ldo + col] = v; };
    (void)N; skinny_gemm<NT, 2>(lds, A, Bt, K, t_begin, t_end, t_stride, rowof, epi, tid, wave, lane);
}
__device__ __forceinline__ void skinny_assign(int ntiles, int nwg, int q, int bx, int G, int& t_begin, int& t_end, int& t_stride) {
    const int rem = nwg % G;
    if (rem == 0) { t_begin = bx; t_end = ntiles; t_stride = G; return; }
    const int nidle = G - rem, nit = ntiles < nidle * q ? ntiles : nidle * q;
    if (bx >= rem) { t_begin = bx - rem; t_end = nit; t_stride = nidle; } else { t_begin = nit + bx; t_end = ntiles; t_stride = rem; }
}

constexpr int GT_VS = 544, GT_WS = 272;
constexpr int GT_OFF_V = 0, GT_OFF_W = 128 * GT_VS, GT_OFF_MR = GT_OFF_W + 128 * GT_WS;
static_assert(GT_OFF_MR + 1024 <= RING_BYTES, "gating LDS");
__device__ __forceinline__ void gate_units(LAS unsigned char* lds, int u0, int u_end, int u_stride, const bf16* U, const bf16* V, const float* vstat, const float* ln_g, const float* ln_b,
                                           const float* w_s, const float* b_s, bf16* GATED, float* gvp, int tid_in, int wave, int lane_in) {
    if (u0 >= u_end) return;
    int tid = tid_in; asm volatile("" : "+v"(tid));
    LAS unsigned char* Vs = lds + GT_OFF_V; LAS unsigned char* Ws = lds + GT_OFF_W; LAS f32x2g* MR = (LAS f32x2g*)(lds + GT_OFF_MR);
    v4u vraw[8], uraw[8]; f32x4 st[8];
    auto ld_v = [&](int u) { const int t0 = (u >> 4) * 128, g = u & 15;
#pragma unroll
        for (int i = 0; i < 8; ++i) vraw[i] = *(const GAS v4u*)(V + (size_t)(t0 + (tid >> 5) + 16 * i) * D + g * 256 + (tid & 31) * 8); };
    auto ld_u = [&](int u) { const int t0 = (u >> 4) * 128, g = u & 15;
#pragma unroll
        for (int i = 0; i < 8; ++i) uraw[i] = *(const GAS v4u*)(U + (size_t)(t0 + (tid >> 5) + 16 * i) * D + g * 256 + (tid & 31) * 8); };
    auto ld_st = [&](int u) { const GAS f32x4* p = (const GAS f32x4*)(vstat + ((size_t)((u >> 4) * 128 + (tid >> 2)) * 64 + 16 * (tid & 3)) * 2);
#pragma unroll
        for (int j = 0; j < 8; ++j) st[j] = p[j]; };
    ld_st(u0); ld_v(u0); ld_u(u0);
    int gcur = -1; f32x4 g0, g1, b0, b1; float bb[8];
    for (int u = u0; u < u_end; u += u_stride) {
        tid = tid_in; asm volatile("" : "+v"(tid)); const int lane = tid & 63, fr = lane & 15, fq = lane >> 4, ch = tid & 31; (void)lane_in;
        const int cidx = u >> 4, g = u & 15, t0 = cidx * 128, un = u + u_stride; const bool hn = un < u_end;
        { const int tok = tid >> 2, qd = tid & 3; float sm = 0.f, q = 0.f;
#pragma unroll
          for (int j = 0; j < 8; ++j) { const f32x4 x = st[j]; sm += x.x + x.z; q += x.y + x.w; }
          sm += __shfl_xor(sm, 1); sm += __shfl_xor(sm, 2); q += __shfl_xor(q, 1); q += __shfl_xor(q, 2);
          const float mean = sm * (1.0f / D); const float var = fmaxf(q * (1.0f / D) - mean * mean, 0.f);
          if (qd == 0) MR[tok] = (f32x2g){mean, 1.0f / sqrtf(var + NORM_EPS)}; }
        if (g != gcur) { gcur = g;
#pragma unroll
            for (int i = 0; i < 8; ++i) { const int idx = tid + 512 * i, t = idx >> 5, s4 = (idx & 31) * 4; const f32x4 w = *(const GAS f32x4*)(w_s + ((size_t)g * 128 + t) * 128 + s4);
                u32x2g o; o.x = cvtpk(s4 + 0 <= t ? w.x : 0.f, s4 + 1 <= t ? w.y : 0.f); o.y = cvtpk(s4 + 2 <= t ? w.z : 0.f, s4 + 3 <= t ? w.w : 0.f);
                *(LAS u32x2g*)(Ws + t * GT_WS + s4 * 2) = o; }
            g0 = *(const GAS f32x4*)(ln_g + g * 256 + ch * 8); g1 = *(const GAS f32x4*)(ln_g + g * 256 + ch * 8 + 4); b0 = *(const GAS f32x4*)(ln_b + g * 256 + ch * 8); b1 = *(const GAS f32x4*)(ln_b + g * 256 + ch * 8 + 4);
#pragma unroll
            for (int tt = 0; tt < 8; ++tt) bb[tt] = b_s[g * 128 + 16 * tt + fr]; }
        __syncthreads();
        { const bool last = (cidx & 15) == 15;
#pragma unroll
          for (int i = 0; i < 8; ++i) { const int row = (tid >> 5) + 16 * i; const v4u x = vraw[i]; const f32x2g mr = MR[row];
              f32x4 a, b; a.x = (bflo(x.x) - mr.x) * mr.y * g0.x + b0.x; a.y = (bfhi(x.x) - mr.x) * mr.y * g0.y + b0.y; a.z = (bflo(x.y) - mr.x) * mr.y * g0.z + b0.z; a.w = (bfhi(x.y) - mr.x) * mr.y * g0.w + b0.w;
              b.x = (bflo(x.z) - mr.x) * mr.y * g1.x + b1.x; b.y = (bfhi(x.z) - mr.x) * mr.y * g1.y + b1.y; b.z = (bflo(x.w) - mr.x) * mr.y * g1.z + b1.z; b.w = (bfhi(x.w) - mr.x) * mr.y * g1.w + b1.w;
              if (last) { float* o = gvp + ((size_t)((cidx >> 4) * 128 + row)) * D + g * 256 + ch * 8; *(GAS f32x4*)o = a; *(GAS f32x4*)(o + 4) = b; }
              v4u w; w.x = cvtpk(a.x, a.y); w.y = cvtpk(a.z, a.w); w.z = cvtpk(b.x, b.y); w.w = cvtpk(b.z, b.w);
              *(LAS v4u*)(Vs + row * GT_VS + ch * 16) = w; } }
        if (hn) ld_v(un);
        __syncthreads();
        f32x4 acc[8][2];
        { bf16x8 vf[2][4];
#pragma unroll
          for (int ct = 0; ct < 2; ++ct)
#pragma unroll
              for (int ks = 0; ks < 4; ++ks) { LAS const unsigned char* p = Vs + (32 * ks + 8 * fq + (fr >> 2)) * GT_VS + (32 * wave + 16 * ct + 4 * (fr & 3)) * 2;
                  vf[ct][ks] = cat8(ldtr(p), ldtr(p + 4 * GT_VS)); }
#pragma unroll
          for (int tt = 0; tt < 8; ++tt) { acc[tt][0] = (f32x4){0.f, 0.f, 0.f, 0.f}; acc[tt][1] = (f32x4){0.f, 0.f, 0.f, 0.f};
#pragma unroll
              for (int ks = 0; ks < 4; ++ks) if (ks <= (tt >> 1)) { const bf16x8 wf = *(LAS const bf16x8*)(Ws + (16 * tt + fr) * GT_WS + (32 * ks + 8 * fq) * 2);
                  acc[tt][0] = __builtin_amdgcn_mfma_f32_16x16x32_bf16(vf[0][ks], wf, acc[tt][0], 0, 0, 0); acc[tt][1] = __builtin_amdgcn_mfma_f32_16x16x32_bf16(vf[1][ks], wf, acc[tt][1], 0, 0, 0); } } }
        __syncthreads();
#pragma unroll
        for (int tt = 0; tt < 8; ++tt) { const int t = 16 * tt + fr;
#pragma unroll
            for (int ct = 0; ct < 2; ++ct) { u32x2g o; o.x = cvtpk(acc[tt][ct][0] + bb[tt], acc[tt][ct][1] + bb[tt]); o.y = cvtpk(acc[tt][ct][2] + bb[tt], acc[tt][ct][3] + bb[tt]);
                *(LAS u32x2g*)(Vs + t * GT_VS + (32 * wave + 16 * ct + 4 * fq) * 2) = o; } }
        if (hn) ld_st(un);
        __syncthreads();
#pragma unroll
        for (int i = 0; i < 8; ++i) { const int row = (tid >> 5) + 16 * i; const v4u sv = *(LAS const v4u*)(Vs + row * GT_VS + ch * 16); const size_t go = (size_t)(t0 + row) * D + g * 256 + ch * 8; const v4u x = uraw[i];
            v4u w; w.x = cvtpk(bflo(x.x) * bflo(sv.x), bfhi(x.x) * bfhi(sv.x)); w.y = cvtpk(bflo(x.y) * bflo(sv.y), bfhi(x.y) * bfhi(sv.y));
            w.z = cvtpk(bflo(x.z) * bflo(sv.z), bfhi(x.z) * bfhi(sv.z)); w.w = cvtpk(bflo(x.w) * bflo(sv.w), bfhi(x.w) * bfhi(sv.w));
            *(GAS v4u*)(GATED + go) = w; }
        if (hn) ld_u(un);
        __syncthreads();
    }
}

constexpr int AT_KS = 144;
constexpr int AT_OFF_K = 0, AT_OFF_V = 256 * AT_KS;
static_assert(AT_OFF_V + 272 * AT_KS <= RING_BYTES, "attention LDS");
template <bool FIRST> __device__ __forceinline__ void attn_unit(LAS unsigned char* lds, int b, int kvh, int qb,     const bf16* QKV, bf16* O, const float* sinks, int tid, int wave, int lane) {
    const int fr = lane & 15, fq = lane >> 4;
    LAS unsigned char* Ks = lds + AT_OFF_K; LAS unsigned char* Vs = lds + AT_OFF_V;
    const size_t tokbase = (size_t)b * SEQ + (size_t)128 * qb;
#pragma unroll
    for (int i = 0; i < 4; ++i) { const int idx = tid + 512 * i, row = idx >> 3, ch = idx & 7; v4u kx = (v4u){0u, 0u, 0u, 0u}, vx = (v4u){0u, 0u, 0u, 0u};
        if (qb > 0 || row >= 128) { const bf16* src = QKV + (tokbase - 128 + row) * NQKV + 4096 + kvh * 64 + ch * 8; kx = *(const GAS v4u*)src; vx = *(const GAS v4u*)(src + 512); }
        *(LAS v4u*)(Ks + row * AT_KS + ch * 16) = kx; *(LAS v4u*)(Vs + row * AT_KS + ch * 16) = vx; }
    if (tid < 128) *(LAS v4u*)(Vs + (256 + (tid >> 3)) * AT_KS + (tid & 7) * 16) = (v4u){0u, 0u, 0u, 0u};
    __syncthreads();
    const int h = kvh * 8 + wave; const float sink = sinks[h];
    for (int qt = 0; qt < 8; ++qt) {
        const bf16* qp = QKV + (tokbase + 16 * qt + fr) * NQKV + h * 64 + 8 * fq;
        const bf16x8 q0 = *(const GAS bf16x8*)qp, q1 = *(const GAS bf16x8*)(qp + 32);
        f32x4 s[9];
        LAS const unsigned char* kbase = Ks + (16 * qt + fr) * AT_KS + fq * 16;
#pragma unroll
        for (int r = 0; r < 9; ++r) { LAS const unsigned char* kp = kbase + r * 16 * AT_KS;
            f32x4 a = (f32x4){0.f, 0.f, 0.f, 0.f};
            a = __builtin_amdgcn_mfma_f32_16x16x32_bf16(*(LAS const bf16x8*)kp, q0, a, 0, 0, 0);
            a = __builtin_amdgcn_mfma_f32_16x16x32_bf16(*(LAS const bf16x8*)(kp + 64), q1, a, 0, 0, 0); s[r] = a; }
        constexpr float SC2 = ATTN_SCALE * 1.44269504089f;
        const float sink2 = sink * 1.44269504089f; float mx = sink2;
#pragma unroll
        for (int r = 0; r < 9; ++r)
#pragma unroll
            for (int i = 0; i < 4; ++i) { const int d = 4 * fq + i - fr;
                bool ok = (r == 0) ? (d >= 0) : ((r == 8) ? (d <= 0) : true);
                if (FIRST) ok = ok && (16 * (qt + r) + 4 * fq + i >= 128);
                const float v = ok ? s[r][i] * SC2 : -INFINITY; s[r][i] = v; mx = fmaxf(mx, v); }
        mx = fmaxf(mx, __shfl_xor(mx, 16)); mx = fmaxf(mx, __shfl_xor(mx, 32));
        float l = 0.f;
#pragma unroll
        for (int r = 0; r < 9; ++r)
#pragma unroll
            for (int i = 0; i < 4; ++i) { const float p = __builtin_amdgcn_exp2f(s[r][i] - mx); s[r][i] = p; l += p; }
        l += __shfl_xor(l, 16); l += __shfl_xor(l, 32); l += __builtin_amdgcn_exp2f(sink2 - mx);
        const float inv = 1.0f / l;
        f32x4 o[4];
#pragma unroll
        for (int dt = 0; dt < 4; ++dt) o[dt] = (f32x4){0.f, 0.f, 0.f, 0.f};
        LAS const unsigned char* vbase = Vs + (16 * qt + 4 * fq + (fr >> 2)) * AT_KS + (4 * (fr & 3)) * 2;
#pragma unroll
        for (int ks = 0; ks < 5; ++ks) { v4u pw; pw.x = cvtpk(s[2 * ks][0], s[2 * ks][1]); pw.y = cvtpk(s[2 * ks][2], s[2 * ks][3]);
            if (ks < 4) { pw.z = cvtpk(s[2 * ks + 1][0], s[2 * ks + 1][1]); pw.w = cvtpk(s[2 * ks + 1][2], s[2 * ks + 1][3]); } else { pw.z = 0u; pw.w = 0u; }
            const bf16x8 pb = __builtin_bit_cast(bf16x8, pw);
#pragma unroll
            for (int dt = 0; dt < 4; ++dt) { LAS const unsigned char* vp = vbase + ks * 32 * AT_KS + dt * 32;
                o[dt] = __builtin_amdgcn_mfma_f32_16x16x32_bf16(cat8(ldtr(vp), ldtr(vp + 16 * AT_KS)), pb, o[dt], 0, 0, 0); } }
        bf16* op = O + (tokbase + 16 * qt + fr) * D + h * 64 + 4 * fq;
#pragma unroll
        for (int dt = 0; dt < 4; ++dt) { u32x2g w; w.x = cvtpk(o[dt][0] * inv, o[dt][1] * inv); w.y = cvtpk(o[dt][2] * inv, o[dt][3] * inv); *(GAS u32x2g*)(op + 16 * dt) = w; }
    }
    __syncthreads();
}

__device__ __forceinline__ void attn_sample_task(int b, int h, const float* qkvs, const float* ck, const float* cv, const float* sinks, bf16* os, int lane) {
    const int kvh = h >> 3;
    const float q = qkvs[(size_t)b * NQKV + h * 64 + lane] * ATTN_SCALE;
    const float* kp = ck + ((size_t)b * 128 * 8 + kvh) * 64 + lane; const float* vp = cv + ((size_t)b * 128 * 8 + kvh) * 64 + lane;
    const float knew = qkvs[(size_t)b * NQKV + 4096 + kvh * 64 + lane], vnew = qkvs[(size_t)b * NQKV + 4608 + kvh * 64 + lane];
    float s[2] = {0.f, 0.f};
#pragma unroll
    for (int hb = 0; hb < 2; ++hb) { float kk[64];
#pragma unroll
        for (int j = 0; j < 64; ++j) kk[j] = kp[(size_t)(64 * hb + j) * 512];
#pragma unroll
        for (int j = 0; j < 64; ++j) { const float sj = wave_sum(q * kk[j]); s[hb] = (lane == j) ? sj : s[hb]; }
        asm volatile("" ::: "memory"); }
    const float snew = wave_sum(q * knew), sink = sinks[h];
    const float m = fmaxf(fmaxf(wave_max(fmaxf(s[0], s[1])), snew), sink);
    const float p0 = __expf(s[0] - m), p1 = __expf(s[1] - m), pnew = __expf(snew - m);
    const float l = wave_sum(p0 + p1) + pnew + __expf(sink - m);
    float o = pnew * vnew;
#pragma unroll
    for (int hb = 0; hb < 2; ++hb) { float vv[64]; const float ph = hb ? p1 : p0;
#pragma unroll
        for (int j = 0; j < 64; ++j) vv[j] = vp[(size_t)(64 * hb + j) * 512];
#pragma unroll
        for (int j = 0; j < 64; ++j) o += __int_as_float(__builtin_amdgcn_readlane(__float_as_int(ph), j)) * vv[j];
        asm volatile("" ::: "memory"); }
    os[(size_t)b * D + h * 64 + lane] = (bf16)f2bf(o / l);
}


struct Args { const float* in[N_IN]; float* out; unsigned char* ws; };
static_assert(sizeof(Args) == (N_IN + 2) * 8, "Args has no padding");

#ifndef PHMASK
#define PHMASK 0xFFFFFFFFu
#endif
#define PH(k) if constexpr (((PHMASK) >> (k)) & 1u)
#ifndef REPMASK
#define REPMASK 0u
#endif
#ifndef NREP_GEMM
#define NREP_GEMM 1
#endif
#ifndef SKQ_UP
#define SKQ_UP 8
#endif
#ifndef PHREP5
#define PHREP5 1
#endif
#ifndef PHRMASK
#define PHRMASK 0u
#endif
#ifndef PHRN
#define PHRN 4
#endif
#define PHR(k) ((((PHRMASK) >> (k)) & 1u) ? PHRN : 1)
#ifndef P0S_REP
#define P0S_REP 1
#endif
#ifndef P0I_REP
#define P0I_REP 1
#endif
#ifndef P0R_REP
#define P0R_REP 1
#endif
#ifndef P0D_REP
#define P0D_REP 0
#endif
#ifndef P0O_REP
#define P0O_REP 0
#endif
#ifndef NREP_SK
#define NREP_SK 1
#endif
#define NREP(k) ((((REPMASK) >> (k)) & 1u) ? 2 : 1)
#ifndef GREPMASK
#define GREPMASK 0u
#endif
#define NREPG(k) ((((GREPMASK) >> (k)) & 1u) ? 2 : 1)
#define CAS __attribute__((address_space(4)))
#define DEFPTRS() const CAS Args* A_ = kargs; asm volatile("" : "+s"(A_)); int tid_ = tid0; asm volatile("" : "+v"(tid_)); const int tid = tid_, lane = tid & 63, wave = __builtin_amdgcn_readfirstlane(tid >> 6), gw = vcu * NWAVES + wave, gt = vcu * NWAVES * 64 + tid; (void)gw; (void)gt; (void)lane; unsigned char* ws = A_->ws; float* out = A_->out; gu32* ctl = (gu32*)(ws + WS_CTL); const float* xp = A_->in[I_XP]; const float* xs = A_->in[I_XS]; const float* cache_k = A_->in[I_CK]; const float* cache_v = A_->in[I_CV]; const float* state_conv = A_->in[I_SC]; const float* nm_pre = A_->in[I_NMPRE]; const float* nm_post = A_->in[I_NMPOST]; const float* nf_pre = A_->in[I_NFPRE]; const float* nf_post = A_->in[I_NFPOST]; bf16* WIN = (bf16*)(ws + WS_WIN); bf16* WOUT = (bf16*)(ws + WS_WOUT); bf16* WQKV = (bf16*)(ws + WS_WQKV); bf16* WO = (bf16*)(ws + WS_WO); bf16* WUP = (bf16*)(ws + WS_WUP); bf16* WDN = (bf16*)(ws + WS_WDN); bf16* HN = (bf16*)(ws + WS_HN); bf16* U = (bf16*)(ws + WS_U); bf16* V = (bf16*)(ws + WS_V); float* VSTAT = (float*)(ws + WS_VSTAT); bf16* GATED = (bf16*)(ws + WS_GATED); bf16* Y = (bf16*)(ws + WS_Y); bf16* X = (bf16*)(ws + WS_X); float* R2 = (float*)(ws + WS_R2); float* RQ = (float*)(ws + WS_RQ); float* SW = (float*)(ws + WS_SW); unsigned char* XQ = ws + WS_XQ; unsigned char* WQUP = ws + WS_WQUP; unsigned char* WQIN = ws + WS_WQIN; unsigned char* WQQKV = ws + WS_WQQKV; float* CMAX = (float*)(ctl + CW_CMAX); float* HALOB = (float*)(ws + WS_HALOB); float* HALOT = (float*)(ws + WS_HALOT); bf16* ACT = (bf16*)(ws + WS_ACT); bf16* QKV = (bf16*)(ws + WS_QKV); unsigned char* sm = ws + WS_SMP; bf16* HS = (bf16*)(sm + SM_HS); float* ZS = (float*)(sm + SM_ZS); bf16* GS = (bf16*)(sm + SM_GS); float* YS = (float*)(sm + SM_YS); float* XS = (float*)(sm + SM_XS); float* HHS = (float*)(sm + SM_HHS); bf16* ACTS = (bf16*)(sm + SM_ACTS); float* QKVS = (float*)(sm + SM_QKVS); unsigned char* ACTQ = ws + WS_ACTQ; unsigned char* WQDN = ws + WS_WQDN; float* SA = (float*)(ws + WS_SA); unsigned char* HSQ = sm + SM_HSQ; unsigned char* HHSQ_ = sm + SM_HHS; float* SAS = (float*)(sm + SM_SAS); float* HSS = (float*)(sm + SM_HSS);
#define P0_DEFS() \
        constexpr int I_A = 64 * 128, I_B = 64 * 64, I_C = 64 * 80, I_U = 64 * 344, I_D = 172 * 64; \
        constexpr int NITEMS = I_A + 2 * I_B + I_C + 2 * I_D, P0_LATE = 0; (void)P0_LATE; (void)I_U; \
        auto seg = [&](int it) { P0Seg sg; int r = it; sg.up = false; sg.had = false; sg.g = nullptr; sg.cmax = nullptr; \
            if (r < I_A) { sg.W = A_->in[I_WIN]; sg.WT = WIN; sg.g = nm_pre; sg.cmax = CMAX + 2 * DFF2; sg.K = D; sg.N = DZ; sg.item = r; return sg; } r -= I_A; \
            if (r < I_B) { sg.W = A_->in[I_WOUT]; sg.WT = WOUT; sg.K = D; sg.N = D; sg.item = r; return sg; } r -= I_B; \
            if (r < I_C) { sg.W = A_->in[I_WQKV]; sg.WT = WQKV; sg.g = nm_pre + D; sg.cmax = CMAX + 2 * DFF2 + DZ; sg.K = D; sg.N = NQKV; sg.item = r; return sg; } r -= I_C; \
            if (r < I_B) { sg.W = A_->in[I_WO]; sg.WT = WO; sg.K = D; sg.N = D; sg.item = r; return sg; } r -= I_B; \
            { const int l = r >= I_D; sg.W = A_->in[I_WDN] + (size_t)l * DFF * D; sg.WT = WDN + (size_t)l * DFF * D; sg.had = true; sg.cmax = CMAX + QC_DN + l * D; sg.K = DFF; sg.N = D; sg.item = r - l * I_D; return sg; } }; \
        auto convert = [&](int it0, int it_end, int step) {     \
            if (it0 < it_end) { f32x4 va[16], vb[16]; P0Seg sa = seg(it0), sb; p0_load(sa, lane, va); \
                for (int it = it0; it < it_end; it += 2 * step) { \
                    const bool hb = it + step < it_end; if (hb) { sb = seg(it + step); p0_load(sb, lane, vb); } \
                    p0_store(sa, lane, va, T); \
                    const bool ha = it + 2 * step < it_end; if (ha) { sa = seg(it + 2 * step); p0_load(sa, lane, va); } \
                    if (hb) p0_store(sb, lane, vb, T); } } }; \
        auto grab = [&]() { unsigned v = 0u; if (lane == 0) v = xb_add((unsigned*)(ws + WS_CTL) + CW_ITEM, 1u); return (int)__builtin_amdgcn_readfirstlane(v); };     \
        auto convert_dyn = [&]() {     \
            f32x4 va[16], vb[16]; P0Seg sa, sb; int ia = grab(); if (ia < NITEMS) { sa = seg(ia); p0_load(sa, lane, va); } \
            while (ia < NITEMS) { const int ib = grab(); const bool hb = ib < NITEMS; if (hb) { sb = seg(ib); p0_load(sb, lane, vb); } \
                p0_store(sa, lane, va, T); \
                ia = hb ? grab() : NITEMS; if (ia < NITEMS) { sa = seg(ia); p0_load(sa, lane, va); } \
                if (hb) p0_store(sb, lane, vb, T); } };
#define QUANT_WDN_RANGE(I0, I1, T0, TS) \
        for (int idx0 = (I0) + (T0); idx0 < (I1); idx0 += 4 * (TS)) {    \
            v4u xx[4], yy[4]; float mm[4]; \
_Pragma("unroll") \
            for (int u = 0; u < 4; ++u) { const int idx = idx0 + u * (TS); if (idx < (I1)) { const int row = idx / (DFF / 16), ch = idx - row * (DFF / 16); const bf16* src = WDN + (size_t)row * DFF + ch * 16; \
                mm[u] = CMAX[QC_DN + row]; xx[u] = *(const GAS v4u*)src; yy[u] = *(const GAS v4u*)(src + 8); } } \
_Pragma("unroll") \
            for (int u = 0; u < 4; ++u) { const int idx = idx0 + u * (TS); if (idx < (I1)) { const int row = idx / (DFF / 16), ch = idx - row * (DFF / 16); const float m = mm[u]; const float inv = m > 0.f ? 127.0f / m : 0.f; const v4u x = xx[u], y = yy[u]; v4u q; \
                q.x = q8x4(bflo(x.x), bfhi(x.x), bflo(x.y), bfhi(x.y), inv); q.y = q8x4(bflo(x.z), bfhi(x.z), bflo(x.w), bfhi(x.w), inv); q.z = q8x4(bflo(y.x), bfhi(y.x), bflo(y.y), bfhi(y.y), inv); q.w = q8x4(bflo(y.z), bfhi(y.z), bflo(y.w), bfhi(y.w), inv); \
                *(GAS v4u*)(WQDN + (size_t)row * DFF + ch * 16) = q; if (ch == 0) SW[QC_DN + row] = m * (1.0f / 127.0f); } } }
__global__ void __launch_bounds__(NWAVES * 64, 2) fwd(Args args) {
    extern __shared__ __attribute__((aligned(16))) unsigned char lds_raw[];
    LAS unsigned char* lds = (LAS unsigned char*)lds_raw;
    volatile LAS unsigned* MISC = (volatile LAS unsigned*)(lds + MISC_OFF);
    const int tid0 = threadIdx.x;
    const int G = gridDim.x, bx = blockIdx.x;
    const int vcu = (G % 8 == 0) ? (bx % 8) * (G / 8) + bx / 8 : bx;
    const int NGW = G * NWAVES, NGT = G * NWAVES * 64;
    const CAS Args* kargs = (const CAS Args*)__builtin_amdgcn_kernarg_segment_ptr();
    for (int u = tid0; u < (LDS_BYTES - LDSCTL_OFF) / 4; u += NWAVES * 64) ((LAS unsigned*)(lds + LDSCTL_OFF))[u] = 0u;
    __syncthreads();
    XcdBarrier bar = xcd_barrier_post((unsigned*)(kargs->ws + WS_CTL) + CW_BAR, MISC + 8);
#define GRID_BAR() do { XcdBarrier b_ = bar; b_.bar = (unsigned*)(kargs->ws + WS_CTL) + CW_BAR; asm volatile("" : "+s"(b_.x)); xcd_barrier(b_); } while (0)
#define PROMPT_GEMM(EpiT, Eobj, Aptr, Bptr, Nn, Kk) do { pg8::Gemm g_{(const pg8::bf16_t*)(Aptr), (const pg8::bf16_t*)(Bptr), MP, (Nn), (Kk)}; pg8::StaticOrder S_; S_.init(MP, (Nn), G, bx); \
        for (int rg_ = 0; rg_ < NREP_GEMM * NRG_; ++rg_) pg8::gemm_phase<EpiT, pg8::StaticOrder, true, true>(lds + RING_OFF, g_, S_, Eobj); } while (0)

    PH(0) for (int rep_ = 0; rep_ < NREP(0); ++rep_) { DEFPTRS(); if (rep_) __syncthreads();
        LAS unsigned char* T = lds + RING_OFF + wave * 9216;
        P0_DEFS();
        for (int sr_ = 0; sr_ < P0S_REP; ++sr_) { if (sr_) __syncthreads();
        for (int s = vcu, par = 0; s < 2 * (DFF2 / 32); s += G, par ^= 1) { const int l = s >= DFF2 / 32;
            p0_strip_up(lds, A_->in[I_WUP] + (size_t)l * D * DFF2, nf_pre + l * D, WQUP + (size_t)l * D * DFF2, SW + l * DFF2, s - l * (DFF2 / 32), par, lane, wave); } }
        __syncthreads();
        for (int ir_ = 0; ir_ < P0I_REP; ++ir_)
        { constexpr int NSTRIP = 2 * (DFF2 / 32); const int rem_ = NSTRIP % G, nlight = rem_ ? G - rem_ : 0, xtra = 2 * nlight * NWAVES;
          convert(gw, NITEMS - xtra, NGW); if (nlight && vcu >= rem_) convert(NITEMS - xtra + (vcu - rem_) * NWAVES + wave, NITEMS, nlight * NWAVES); (void)convert_dyn; }
        for (int dr_ = 0; dr_ < P0D_REP; ++dr_) convert(NITEMS - 2 * I_D + gw, NITEMS, NGW);
        for (int or_ = 0; or_ < P0O_REP; ++or_) convert(gw, NITEMS - 2 * I_D, NGW);
        for (int rr_ = 0; rr_ < P0R_REP; ++rr_)
        for (int r = gw; r < MP + MS; r += NGW) {
            if (r < MP) { if (EPI_IN_I8) first_row<false>(xp + (size_t)r * D, HN + (size_t)r * D, R2 + r, lane, XQ + (size_t)r * D, RQ + r); else first_row<false>(xp + (size_t)r * D, HN + (size_t)r * D, R2 + r, lane); }
            else first_row<true>(xs + (size_t)(r - MP) * D, HS + (size_t)(r - MP) * D, nullptr, lane);
        }
    }
    GRID_BAR();

    PH(17) _Pragma("unroll") for (int pr_ = 0; pr_ < PHR(17); ++pr_) { if (pr_) GRID_BAR(); DEFPTRS(); constexpr int NQ_ = 2 * DFF2 + (EPI_IN_I8 ? DZ : 0) + (EPI_QKV_I8 ? NQKV : 0);
        for (int idx = gt + 2 * DFF2 * (D / 16); idx < NQ_ * (D / 16); idx += NGT) { int row = idx >> 8;     const int ch = idx & 255; if (!EPI_IN_I8 && row >= 2 * DFF2) row += DZ; const float m = CMAX[row]; const float inv = m > 0.f ? 127.0f / m : 0.f;
            const bf16* src; unsigned char* dst;
            if (row < 2 * DFF2) { src = WUP + (size_t)row * D; dst = WQUP + (size_t)row * D; } else if (row < 2 * DFF2 + DZ) { src = WIN + (size_t)(row - 2 * DFF2) * D; dst = WQIN + (size_t)(row - 2 * DFF2) * D; }
            else { src = WQKV + (size_t)(row - 2 * DFF2 - DZ) * D; dst = WQQKV + (size_t)(row - 2 * DFF2 - DZ) * D; }
            const v4u x = *(const GAS v4u*)(src + ch * 16), y = *(const GAS v4u*)(src + ch * 16 + 8); v4u q;
            q.x = q8x4(bflo(x.x), bfhi(x.x), bflo(x.y), bfhi(x.y), inv); q.y = q8x4(bflo(x.z), bfhi(x.z), bflo(x.w), bfhi(x.w), inv); q.z = q8x4(bflo(y.x), bfhi(y.x), bflo(y.y), bfhi(y.y), inv); q.w = q8x4(bflo(y.z), bfhi(y.z), bflo(y.w), bfhi(y.w), inv);
            *(GAS v4u*)(dst + ch * 16) = q; if (ch == 0) SW[row] = m * (1.0f / 127.0f); }
        QUANT_WDN_RANGE(0, D * (DFF / 16), gt, NGT)
    }
    GRID_BAR();

    PH(1) { DEFPTRS(); constexpr int NRG_ = NREPG(1); pg8::EpiGeluUV E{U, V, VSTAT, EPI_IN_I8 ? RQ : R2, SW + 2 * DFF2}; if (EPI_IN_I8) PROMPT_GEMM(pg8::EpiGeluUV, E, XQ, WQIN, DZ, D / 2); else PROMPT_GEMM(pg8::EpiGeluUV, E, HN, WIN, DZ, D);
      for (int rs_ = 0; rs_ < NREP_SK; ++rs_) skinny_plain<32, 1>(lds, HS, WIN, DZ, D, ZS, DZ, nullptr, bx, DZ / 32, G, tid, wave, lane); }
    GRID_BAR();

    PH(2) { DEFPTRS();
        const float* ln_g = A_->in[I_LNG]; const float* ln_b = A_->in[I_LNB]; const float* w_s = A_->in[I_WS]; const float* b_s = A_->in[I_BS];
        for (int rp_ = 0; rp_ < NREP(2); ++rp_) gate_units(lds, bx, 64 * 16, G, U, V, VSTAT, ln_g, ln_b, w_s, b_s, GATED, out + O_GVP, tid, wave, lane);
        if (gw < MS) {
            const int b = gw; const GAS f32x4* vr = (const GAS f32x4*)(ZS + (size_t)b * DZ + D) + lane; const GAS f32x4* ur = (const GAS f32x4*)(ZS + (size_t)b * DZ) + lane;
            f32x4 v[16]; float s = 0.f;
#pragma unroll
            for (int j = 0; j < 16; ++j) { v[j] = vr[64 * j]; s += (v[j].x + v[j].y) + (v[j].z + v[j].w); }
            const float mean = wave_sum(s) * (1.0f / D); float q = 0.f;
#pragma unroll
            for (int j = 0; j < 16; ++j) { v[j] = v[j] - mean; q += (v[j].x * v[j].x + v[j].y * v[j].y) + (v[j].z * v[j].z + v[j].w * v[j].w); }
            const float rstd = 1.0f / sqrtf(wave_sum(q) * (1.0f / D) + NORM_EPS);
            GAS f32x4* go = (GAS f32x4*)(out + O_GVS + (size_t)b * D) + lane; GAS u32x2g* gs = (GAS u32x2g*)(GS + (size_t)b * D) + lane;
#pragma unroll
            for (int j = 0; j < 16; ++j) { const f32x4 gg = ((const GAS f32x4*)ln_g)[lane + 64 * j], bb = ((const GAS f32x4*)ln_b)[lane + 64 * j]; const f32x4 vn = v[j] * rstd * gg + bb; go[64 * j] = vn;
                const float w00 = w_s[(size_t)j * 128 * 128], b0 = b_s[j * 128]; const f32x4 uu = ur[64 * j]; const f32x4 gt4 = uu * (vn * w00 + b0);
                u32x2g w; w.x = cvtpk(gt4.x, gt4.y); w.y = cvtpk(gt4.z, gt4.w); gs[64 * j] = w; }
        }
    }
    GRID_BAR();

    PH(3) { DEFPTRS(); constexpr int NRG_ = NREPG(3); pg8::EpiBf16B E{Y, D, nullptr}; PROMPT_GEMM(pg8::EpiBf16B, E, GATED, WOUT, D, D);
      for (int rs_ = 0; rs_ < NREP_SK; ++rs_) skinny_plain<16, 0>(lds, GS, WOUT, D, D, YS, D, nullptr, bx, D / 16, G, tid, wave, lane); }
    GRID_BAR();

    PH(4) _Pragma("unroll") for (int pr_ = 0; pr_ < PHR(4); ++pr_) { if (pr_) GRID_BAR(); DEFPTRS();
        for (int r = gw; r < MP; r += 2 * NGW) { const int rb = (r + NGW < MP) ? r + NGW : r; const size_t oa = (size_t)r * D, ob = (size_t)rb * D;
            const int ca_ = ((r & (SEQ - 1)) >= SEQ - 2) ? 32 + 2 * (r / SEQ) + (r & 1) : -1, cb_ = ((rb & (SEQ - 1)) >= SEQ - 2) ? 32 + 2 * (rb / SEQ) + (rb & 1) : -1;
            unsigned char* cqa = ca_ >= 0 ? HSQ + (size_t)ca_ * D : (unsigned char*)nullptr; unsigned char* cqb = cb_ >= 0 ? HSQ + (size_t)cb_ * D : (unsigned char*)nullptr; float* csa = ca_ >= 0 ? HSS + ca_ : (float*)nullptr; float* csb = cb_ >= 0 ? HSS + cb_ : (float*)nullptr;
            resid_norm_row2<bf16, true>(Y + oa, Y + ob, HN + oa, HN + ob, X + oa, X + ob, nm_post, R2 + r, R2 + rb, lane, XQ + oa, XQ + ob, RQ + r, RQ + rb, cqa, cqb, csa, csb); }
        if (gw < MS) { const size_t o = (size_t)gw * D; resid_norm_row(YS + o, xs + o, nm_post, XS + o, (float*)nullptr, HS + o, lane, HSQ + o, HSS + gw); }
    }
    GRID_BAR();

#define FFN_PHASES(L) \
    PH(5 + 8 * (L)) _Pragma("unroll") for (int pr_ = 0; pr_ < PHREP5; ++pr_) { if (pr_) GRID_BAR(); DEFPTRS(); constexpr int NRG_ = NREPG(5 + 8 * (L)); pg8::EpiUpConv E{ACT, HALOB, HALOT, A_->in[I_CW] + (size_t)(L) * 3 * DFF2, A_->in[I_CB] + (size_t)(L) * DFF2, (LAS float*)(lds + XH_OFF), RQ, SW + (L) * DFF2}; \
      PROMPT_GEMM(pg8::EpiUpConv, E, XQ, WQUP + (size_t)(L) * D * DFF2, DFF2, D / 2);     \
      for (int rs_ = 0; rs_ < NREP_SK; ++rs_) { const float* cw = A_->in[I_CW] + (size_t)(L) * 3 * DFF2; const float* cb = A_->in[I_CB] + (size_t)(L) * DFF2; \
        const float* sc = state_conv + (size_t)(L) * MS * 2 * DFF2; float* cvs = out + O_CVS + (size_t)(L) * MS * 2 * DFF2; \
        auto rowof = [](int tile, int c) { return 256 * (tile >> 3) + 16 * (tile & 7) + 128 * c; };     \
        float* cvp = out + O_CVP + (size_t)(L) * NBATCH * 2 * DFF2; \
        const float* swl = SW + (L) * DFF2;     \
        auto epi = [=](int tile, int t, LAS const float* sums) { if (t >= 512 + 128) return; const int b = t >> 4, j = 128 * (tile >> 3) + 16 * (tile & 7) + (t & 15), rg_ = 256 * (tile >> 3) + 16 * (tile & 7) + (t & 15); \
            const float hsr = HSS[b], hg = sums[b * 32 + (t & 15)] * swl[rg_] * hsr, hv = sums[b * 32 + 16 + (t & 15)] * swl[rg_ + 128] * hsr; \
            if (t >= 512) { cvp[(size_t)(b - 32) * DFF2 + j] = hg; cvp[(size_t)(b - 32) * DFF2 + DFF + j] = hv; return; }     \
            const float s0g = sc[((size_t)b * 2 + 0) * DFF2 + j], s1g = sc[((size_t)b * 2 + 1) * DFF2 + j], s0v = sc[((size_t)b * 2 + 0) * DFF2 + DFF + j], s1v = sc[((size_t)b * 2 + 1) * DFF2 + DFF + j]; \
            const float cg = cb[j] + cw[j] * s0g + cw[DFF2 + j] * s1g + cw[2 * DFF2 + j] * hg; \
            const float cv = cb[DFF + j] + cw[DFF + j] * s0v + cw[DFF2 + DFF + j] * s1v + cw[2 * DFF2 + DFF + j] * hv; \
            ACTS[(size_t)b * DFF + j] = (bf16)f2bf(silu_mul(cg, cv)); \
            cvs[((size_t)b * 2 + 0) * DFF2 + j] = s1g; cvs[((size_t)b * 2 + 0) * DFF2 + DFF + j] = s1v; cvs[((size_t)b * 2 + 1) * DFF2 + j] = hg; cvs[((size_t)b * 2 + 1) * DFF2 + DFF + j] = hv; }; \
        int tb_, te_, ts_; skinny_assign(DFF / 16, (MP / 256) * (DFF2 / 256), SKQ_UP, bx, G, tb_, te_, ts_); \
        skinny_i8_resident<32, 3>(lds, HSQ, WQUP + (size_t)(L) * D * DFF2, tb_, te_, ts_, rowof, epi, tid, wave, lane); } } \
    GRID_BAR(); \
    PH(6 + 8 * (L)) _Pragma("unroll") for (int pr_ = 0; pr_ < PHR(6 + 8 * (L)); ++pr_) { if (pr_) GRID_BAR(); DEFPTRS(); const float* cw = A_->in[I_CW] + (size_t)(L) * 3 * DFF2; const float* cb = A_->in[I_CB] + (size_t)(L) * DFF2; \
      for (int idx = gt; idx < 28 * (DFF / 4); idx += NGT) { const int pq = idx / (DFF / 4), j = 4 * (idx - pq * (DFF / 4)), pm = pq + 1 + pq / 7;     \
          const int cg_ = 256 * (j >> 7) + (j & 127); const float* hb = HALOB + (size_t)(pm - 1) * 2 * DFF2 + cg_; const float* ht = HALOT + (size_t)pm * 2 * DFF2 + cg_; \
          const f32x4 g254 = *(const GAS f32x4*)hb, g255 = *(const GAS f32x4*)(hb + DFF2), g0 = *(const GAS f32x4*)ht, g1 = *(const GAS f32x4*)(ht + DFF2); \
          const f32x4 v254 = *(const GAS f32x4*)(hb + 128), v255 = *(const GAS f32x4*)(hb + DFF2 + 128), v0 = *(const GAS f32x4*)(ht + 128), v1 = *(const GAS f32x4*)(ht + DFF2 + 128); \
          const f32x4 wg0 = *(const GAS f32x4*)(cw + j), wg1 = *(const GAS f32x4*)(cw + DFF2 + j), wg2 = *(const GAS f32x4*)(cw + 2 * DFF2 + j), wv0 = *(const GAS f32x4*)(cw + DFF + j), wv1 = *(const GAS f32x4*)(cw + DFF2 + DFF + j), wv2 = *(const GAS f32x4*)(cw + 2 * DFF2 + DFF + j); \
          const f32x4 bg = *(const GAS f32x4*)(cb + j), bv = *(const GAS f32x4*)(cb + DFF + j); \
          const f32x4 cg0 = bg + wg0 * g254 + wg1 * g255 + wg2 * g0, cv0 = bv + wv0 * v254 + wv1 * v255 + wv2 * v0, cg1 = bg + wg0 * g255 + wg1 * g0 + wg2 * g1, cv1 = bv + wv0 * v255 + wv1 * v0 + wv2 * v1; \
          u32x2g o0, o1; o0.x = cvtpk(silu_mul(cg0.x, cv0.x), silu_mul(cg0.y, cv0.y)); o0.y = cvtpk(silu_mul(cg0.z, cv0.z), silu_mul(cg0.w, cv0.w)); o1.x = cvtpk(silu_mul(cg1.x, cv1.x), silu_mul(cg1.y, cv1.y)); o1.y = cvtpk(silu_mul(cg1.z, cv1.z), silu_mul(cg1.w, cv1.w)); \
          *(GAS u32x2g*)(ACT + (size_t)(pm * 256) * DFF + j) = o0; *(GAS u32x2g*)(ACT + (size_t)(pm * 256 + 1) * DFF + j) = o1; } \
    } \
    GRID_BAR(); \
    PH(18 + (L)) _Pragma("unroll") for (int pr_ = 0; pr_ < PHR(18 + (L)); ++pr_) { if (pr_) GRID_BAR(); DEFPTRS();     \
      act_rot_rows(ACT, ACTQ, SA, gw, MP, NGW, lane); \
      if (gw < MS) act_rot_row<true>(ACTS + (size_t)gw * DFF, HHSQ_ + (size_t)gw * DFF, SAS + gw, (bf16*)nullptr, lane);     \
    } \
    GRID_BAR(); \
    PH(7 + 8 * (L)) { DEFPTRS(); constexpr int NRG_ = NREPG(7 + 8 * (L)); pg8::EpiBf16BQ E{Y, D, SA, SW + QC_DN + (L) * D}; PROMPT_GEMM(pg8::EpiBf16BQ, E, ACTQ, WQDN + (size_t)(L) * DFF * D, D, DFF / 2); \
      for (int rs_ = 0; rs_ < NREP_SK; ++rs_) { const float* swd = SW + QC_DN + (L) * D; auto rowof = [](int tile, int c) { return tile * 16 + 16 * c; }; \
        auto epi = [=](int tile, int t, LAS const float* sums) { const int row = t >> 4, col = tile * 16 + (t & 15); YS[(size_t)row * D + col] = sums[t] * SAS[row] * swd[col]; }; \
        skinny_i8<16, 2>(lds, HHSQ_, WQDN + (size_t)(L) * DFF * D, DFF, bx, D / 16, G, rowof, epi, tid, wave, lane); } } \
    GRID_BAR();

    FFN_PHASES(0)

    PH(8) { DEFPTRS();
        for (int r = gw; r < MP; r += 2 * NGW) { const int rb = (EPI_QKV_I8 && r + NGW >= MP) ? r : r + NGW; const size_t oa = (size_t)r * D, ob = (size_t)rb * D;
            if (EPI_QKV_I8) resid_norm_row2<bf16, true>(Y + oa, Y + ob, X + oa, X + ob, X + oa, X + ob, nf_post, R2 + r, R2 + rb, lane, XQ + oa, XQ + ob, RQ + r, RQ + rb);
            else if (rb < MP) resid_norm_row2(Y + oa, Y + ob, X + oa, X + ob, X + oa, X + ob, nf_post, R2 + r, R2 + rb, lane);
            else resid_norm_row(Y + oa, X + oa, nf_post, X + oa, R2 + r, (bf16*)nullptr, lane); }
        if (gw < MS) { const size_t o = (size_t)gw * D; resid_norm_row(YS + o, XS + o, nf_post, XS + o, (float*)nullptr, HS + o, lane); }
    }
    GRID_BAR();

    PH(9) { DEFPTRS(); constexpr int NRG_ = NREPG(9); pg8::EpiQkv E{QKV, A_->in[I_BQKV], out + O_WKP, out + O_WVP, EPI_QKV_I8 ? RQ : R2, SW + 2 * DFF2 + DZ}; if (EPI_QKV_I8) PROMPT_GEMM(pg8::EpiQkv, E, XQ, WQQKV, NQKV, D / 2); else PROMPT_GEMM(pg8::EpiQkv, E, X, WQKV, NQKV, D);
      for (int rs_ = 0; rs_ < NREP_SK; ++rs_) { int tb_, te_, ts_; skinny_assign(NQKV / 32, (MP / 256) * (NQKV / 256), 2, bx, G, tb_, te_, ts_); skinny_plain<32, 0>(lds, HS, WQKV, NQKV, D, QKVS, NQKV, A_->in[I_BQKV], tb_, te_, ts_, tid, wave, lane); }
      { const int rem_ = ((MP / 256) * (NQKV / 256)) % G;
        if (rem_ == 0) { QUANT_WDN_RANGE(D * (DFF / 16), 2 * D * (DFF / 16), gt, NGT) } else if (bx >= rem_) { QUANT_WDN_RANGE(D * (DFF / 16), 2 * D * (DFF / 16), (bx - rem_) * NWAVES * 64 + tid, (G - rem_) * NWAVES * 64) } }
    }
    GRID_BAR();

    PH(10) { DEFPTRS();
        const float* sinks = A_->in[I_SINK];
        for (int rp_ = 0; rp_ < NREP(10); ++rp_) for (int u = bx; u < NBATCH * 8 * 16; u += G) { if ((u & 15) == 0) attn_unit<true>(lds, u >> 7, (u >> 4) & 7, u & 15, QKV, GATED, sinks, tid, wave, lane); else attn_unit<false>(lds, u >> 7, (u >> 4) & 7, u & 15, QKV, GATED, sinks, tid, wave, lane); }
        for (int t = gw; t < MS * 64; t += NGW) attn_sample_task(t >> 6, t & 63, QKVS, cache_k, cache_v, sinks, GS, lane);
        for (int idx0 = gt; idx0 < MS * 128 * 128; idx0 += 4 * NGT) { f32x4 kk[4], vv[4];
#pragma unroll
            for (int u = 0; u < 4; ++u) { const int idx = idx0 + u * NGT; if (idx < MS * 128 * 128) { const int b = idx >> 14, r = (idx >> 7) & 127, c4 = (idx & 127) * 4;
                if (r < 127) { kk[u] = *(const GAS f32x4*)(cache_k + ((size_t)b * 128 + r + 1) * 512 + c4); vv[u] = *(const GAS f32x4*)(cache_v + ((size_t)b * 128 + r + 1) * 512 + c4); }
                else { kk[u] = *(const GAS f32x4*)(QKVS + (size_t)b * NQKV + 4096 + c4); vv[u] = *(const GAS f32x4*)(QKVS + (size_t)b * NQKV + 4608 + c4); } } }
#pragma unroll
            for (int u = 0; u < 4; ++u) { const int idx = idx0 + u * NGT; if (idx < MS * 128 * 128) { const int b = idx >> 14, r = (idx >> 7) & 127, c4 = (idx & 127) * 4;
                *(GAS f32x4*)(out + O_WKS + ((size_t)b * 128 + r) * 512 + c4) = kk[u]; *(GAS f32x4*)(out + O_WVS + ((size_t)b * 128 + r) * 512 + c4) = vv[u]; } } }
    }
    GRID_BAR();

    PH(11) { DEFPTRS(); constexpr int NRG_ = NREPG(11); pg8::EpiBf16B E{Y, D, A_->in[I_BO]}; PROMPT_GEMM(pg8::EpiBf16B, E, GATED, WO, D, D);
      for (int rs_ = 0; rs_ < NREP_SK; ++rs_) skinny_plain<16, 0>(lds, GS, WO, D, D, YS, D, A_->in[I_BO], bx, D / 16, G, tid, wave, lane); }
    GRID_BAR();

    PH(12) { DEFPTRS();
        for (int r = gw; r < MP; r += 2 * NGW) { const int rb = (r + NGW < MP) ? r + NGW : r; const size_t oa = (size_t)r * D, ob = (size_t)rb * D;
            const int ca_ = ((r & (SEQ - 1)) >= SEQ - 2) ? 32 + 2 * (r / SEQ) + (r & 1) : -1, cb_ = ((rb & (SEQ - 1)) >= SEQ - 2) ? 32 + 2 * (rb / SEQ) + (rb & 1) : -1;
            unsigned char* cqa = ca_ >= 0 ? HSQ + (size_t)ca_ * D : (unsigned char*)nullptr; unsigned char* cqb = cb_ >= 0 ? HSQ + (size_t)cb_ * D : (unsigned char*)nullptr; float* csa = ca_ >= 0 ? HSS + ca_ : (float*)nullptr; float* csb = cb_ >= 0 ? HSS + cb_ : (float*)nullptr;
            resid_norm_row2<bf16, true>(Y + oa, Y + ob, X + oa, X + ob, X + oa, X + ob, nm_post + D, R2 + r, R2 + rb, lane, XQ + oa, XQ + ob, RQ + r, RQ + rb, cqa, cqb, csa, csb); }
        if (gw < MS) { const size_t o = (size_t)gw * D; resid_norm_row(YS + o, XS + o, nm_post + D, XS + o, (float*)nullptr, HS + o, lane, HSQ + o, HSS + gw); }
    }
    GRID_BAR();

    FFN_PHASES(1)

    PH(16) _Pragma("unroll") for (int pr_ = 0; pr_ < PHR(16); ++pr_) { if (pr_) GRID_BAR(); DEFPTRS();
        for (int r = gw; r < MP; r += 2 * NGW) { const int rb = r + NGW; const size_t oa = (size_t)r * D, ob = (size_t)rb * D;
            if (rb < MP) final_row2(Y + oa, Y + ob, X + oa, X + ob, out + O_Y + oa, out + O_Y + ob, nf_post + D, lane);
            else resid_norm_row(Y + oa, X + oa, nf_post + D, out + O_Y + oa, (float*)nullptr, (bf16*)nullptr, lane); }
        if (gw < MS) { const size_t o = (size_t)gw * D; resid_norm_row(YS + o, XS + o, nf_post + D, out + O_YS + o, (float*)nullptr, (bf16*)nullptr, lane); }
    }
#undef FFN_PHASES
#undef PROMPT_GEMM
#undef GRID_BAR
}

extern "C" void kernel_launch(void* const* d_in, const int* in_sizes, int n_in, void* d_out, int out_size, void* d_ws, size_t ws_size, hipStream_t stream) {
    static int grid = 0;
    if (grid == 0) {
        if (n_in != N_IN || out_size != (int)O_END || ws_size < WS_END) { fprintf(stderr, "kernel_launch: unexpected problem (n_in %d, out %d, ws %zu; need %d, %zu, >= %zu); nothing launched\n", n_in, out_size, ws_size, (int)N_IN, (size_t)O_END, (size_t)WS_END); grid = -1; return; }
        int dev = 0, cus = 0, per_cu = 0;
        if (hipGetDevice(&dev) != hipSuccess || hipDeviceGetAttribute(&cus, hipDeviceAttributeMultiprocessorCount, dev) != hipSuccess) { grid = -1; return; }
        if (hipFuncSetAttribute((const void*)fwd, hipFuncAttributeMaxDynamicSharedMemorySize, LDS_BYTES) != hipSuccess) { fprintf(stderr, "kernel_launch: hipFuncSetAttribute failed\n"); grid = -1; return; }
        if (hipOccupancyMaxActiveBlocksPerMultiprocessor(&per_cu, (const void*)fwd, NWAVES * 64, LDS_BYTES) != hipSuccess || per_cu < 1) { fprintf(stderr, "kernel_launch: occupancy query says %d blocks per CU\n", per_cu); (void)hipGetLastError(); grid = -1; return; }
        grid = cus;
    }
    if (grid < 0) return;
    if (hipMemsetAsync((char*)d_ws + WS_CTL, 0, CTL_ZERO_BYTES2, stream) != hipSuccess) return;
    Args a{};
    for (int i = 0; i < N_IN; ++i) a.in[i] = (const float*)d_in[i];
    a.out = (float*)d_out; a.ws = (unsigned char*)d_ws;
    hipLaunchKernelGGL(fwd, dim3(grid), dim3(NWAVES * 64), LDS_BYTES, stream, a);
}
```
